# Optimizing an MI355X kernel written in HIP

```python
import math
import jax, jax.numpy as jnp
from jax import lax
import numpy as np

D_MODEL = 2048
BATCH = 4
SEQ = 4096
DEPTH = 2

HEAD_DIM = 128
CHUNK = 128
QB = 128
N_A_GROUPS = 8
A_WIDTH = N_A_GROUPS * HEAD_DIM
N_B_HEADS = 8
DILATED_CONFIGS = ((128, 1), (512, 4), (2048, 16))
N_B_GROUPS = len(DILATED_CONFIGS)
B_WIDTH = N_B_HEADS * HEAD_DIM
MIX_WIDTH = A_WIDTH + B_WIDTH
IN_WIDTH = 2 * A_WIDTH + N_B_GROUPS * B_WIDTH + 2 * B_WIDTH
D_FF = -(-8 * D_MODEL // (3 * 256)) * 256
ROPE_THETA = 10000.0
EPS = 1e-6

kernel_name = "hybrid_gmlp_dilated_attn_block"


def rms_norm(x, g):
    x32 = x.astype(jnp.float32)
    y = x32 * lax.rsqrt(jnp.mean(x32 * x32, axis=-1, keepdims=True) + EPS)
    return (y * g.astype(jnp.float32)).astype(x.dtype)


def layer_norm(x, g, b):
    x32 = x.astype(jnp.float32)
    mu = jnp.mean(x32, axis=-1, keepdims=True)
    var = jnp.mean(jnp.square(x32 - mu), axis=-1, keepdims=True)
    y = (x32 - mu) * lax.rsqrt(var + EPS)
    return (y * g.astype(jnp.float32) + b.astype(jnp.float32)).astype(x.dtype)


def rope_tables(seq):
    pos = jnp.arange(seq, dtype=jnp.float32)
    inv_freq = 1.0 / (ROPE_THETA ** (jnp.arange(0, HEAD_DIM, 2, dtype=jnp.float32) / HEAD_DIM))
    ang = pos[:, None] * inv_freq[None, :]
    return jnp.cos(ang), jnp.sin(ang)


def apply_rope(x, cos, sin):
    half = HEAD_DIM // 2
    x32 = x.astype(jnp.float32)
    x1, x2 = x32[..., :half], x32[..., half:]
    c = cos[None, :, None, :]
    s = sin[None, :, None, :]
    return jnp.concatenate([x1 * c - x2 * s, x2 * c + x1 * s], axis=-1).astype(x.dtype)


def chunked_spatial_gating(z, ln_g, ln_b, w_s, b_s):
    B, S, _ = z.shape
    z = jax.nn.gelu(z, approximate=False)
    u, v = jnp.split(z, 2, axis=-1)
    v = layer_norm(v.reshape(B, S, N_A_GROUPS, HEAD_DIM), ln_g, ln_b)
    v = v.reshape(B, S // CHUNK, CHUNK, N_A_GROUPS, HEAD_DIM)
    causal = jnp.tril(jnp.ones((CHUNK, CHUNK), dtype=w_s.dtype))
    w = w_s * causal[None]
    gate = jnp.einsum('gij,bnjgc->bnigc', w, v) + b_s.T[None, None, :, :, None]
    return u * gate.reshape(B, S, A_WIDTH).astype(u.dtype)


def _to_residue_blocks(x, r, pad):
    B, S = x.shape[:2]
    rest = x.shape[2:]
    x = jnp.pad(x, ((0, 0), (0, pad)) + ((0, 0),) * len(rest))
    L = (S + pad) // r
    x = jnp.moveaxis(x.reshape((B, L, r) + rest), 2, 1)
    return x.reshape((B, r, L // QB, QB) + rest)


def _from_residue_blocks(x, S):
    B, r, nb = x.shape[:3]
    rest = x.shape[4:]
    x = jnp.moveaxis(x.reshape((B, r, nb * QB) + rest), 1, 2)
    return x.reshape((B, nb * QB * r) + rest)[:, :S]


def dilated_branch(q, k, v, window, dilation):
    B, S, H, D = q.shape
    r = dilation
    w_sub = window // dilation
    pad = (-S) % (r * QB)
    qb = _to_residue_blocks(q, r, pad).astype(jnp.float32)
    kb = _to_residue_blocks(k, r, pad).astype(jnp.float32)
    vb = _to_residue_blocks(v, r, pad).astype(jnp.float32)
    nb = qb.shape[2]
    blk_pad = ((0, 0), (0, 0), (1, 0), (0, 0), (0, 0), (0, 0))
    kk = jnp.concatenate([jnp.pad(kb, blk_pad)[:, :, :-1], kb], axis=3)
    vv = jnp.concatenate([jnp.pad(vb, blk_pad)[:, :, :-1], vb], axis=3)
    s = jnp.einsum('brnqhd,brnkhd->brnhqk', qb, kk) * (D ** -0.5)
    qi = jnp.arange(QB)[:, None]
    kj = jnp.arange(2 * QB)[None, :]
    band = (kj <= QB + qi) & (kj >= QB + qi - w_sub)
    valid = (jnp.arange(nb) > 0)[:, None, None] | (kj >= QB)[None]
    mask = band[None] & valid
    s = jnp.where(mask[None, None, :, None], s, -jnp.inf)
    m = jnp.max(s, axis=-1, keepdims=True)
    p = jnp.exp(s - m)
    l = jnp.sum(p, axis=-1, keepdims=True)
    o = jnp.einsum('brnhqk,brnkhd->brnqhd', p, vv) / jnp.transpose(l, (0, 1, 2, 4, 3, 5))
    lse = jnp.transpose((m + jnp.log(l))[..., 0], (0, 1, 2, 4, 3))
    return _from_residue_blocks(o, S), _from_residue_blocks(lse, S)


def dilated_attention(q, k, v, cos, sin, q_gain, k_gain):
    B, S = q.shape[:2]
    q = q.reshape(B, S, N_B_GROUPS * N_B_HEADS, HEAD_DIM)
    k = k.reshape(B, S, N_B_HEADS, HEAD_DIM)
    v = v.reshape(B, S, N_B_HEADS, HEAD_DIM)
    q = apply_rope(rms_norm(q, q_gain), cos, sin).reshape(B, S, N_B_GROUPS, N_B_HEADS, HEAD_DIM)
    k = apply_rope(rms_norm(k, k_gain), cos, sin)
    outs, lses = [], []
    for gi, (window, dilation) in enumerate(DILATED_CONFIGS):
        o, lse = dilated_branch(q[:, :, gi], k, v, window, dilation)
        outs.append(o)
        lses.append(lse)
    alpha = jax.nn.softmax(jnp.stack(lses, axis=0), axis=0)
    o = jnp.sum(alpha[..., None] * jnp.stack(outs, axis=0), axis=0)
    return o.reshape(B, S, B_WIDTH).astype(v.dtype)


def setup_inputs(seed: int = 0) -> dict:
    key = jax.random.key(seed)
    ks = jax.random.split(key, 17)
    f32 = jnp.float32
    nrm = lambda k, shape, scale: jax.random.normal(k, shape, f32) * scale
    gain = lambda k, shape: 1.0 + 0.02 * jax.random.normal(k, shape, f32)
    return {
        "x": jax.random.normal(ks[0], (BATCH, SEQ, D_MODEL), f32),
        "mix_norm": gain(ks[1], (DEPTH, D_MODEL)),
        "w_in": nrm(ks[2], (DEPTH, D_MODEL, IN_WIDTH), D_MODEL ** -0.5),
        "a_ln_g": gain(ks[3], (DEPTH, N_A_GROUPS, HEAD_DIM)),
        "a_ln_b": nrm(ks[4], (DEPTH, N_A_GROUPS, HEAD_DIM), 0.02),
        "a_w_s": nrm(ks[5], (DEPTH, N_A_GROUPS, CHUNK, CHUNK), CHUNK ** -0.5),
        "a_b_s": gain(ks[6], (DEPTH, N_A_GROUPS, CHUNK)),
        "q_norm": gain(ks[7], (DEPTH, HEAD_DIM)),
        "k_norm": gain(ks[8], (DEPTH, HEAD_DIM)),
        "a_out_norm": gain(ks[9], (DEPTH, A_WIDTH)),
        "b_out_norm": gain(ks[10], (DEPTH, B_WIDTH)),
        "w_out": nrm(ks[11], (DEPTH, MIX_WIDTH, D_MODEL), MIX_WIDTH ** -0.5),
        "ffn_norm": gain(ks[12], (DEPTH, D_MODEL)),
        "w_gate": nrm(ks[13], (DEPTH, D_MODEL, D_FF), D_MODEL ** -0.5),
        "w_up": nrm(ks[14], (DEPTH, D_MODEL, D_FF), D_MODEL ** -0.5),
        "w_down": nrm(ks[15], (DEPTH, D_FF, D_MODEL), D_FF ** -0.5),
    }


def reference(x, mix_norm, w_in, a_ln_g, a_ln_b, a_w_s, a_b_s, q_norm, k_norm,
              a_out_norm, b_out_norm, w_out, ffn_norm, w_gate, w_up, w_down):
    B, S, _ = x.shape
    cos, sin = rope_tables(S)
    c_a = 2 * A_WIDTH
    c_q = c_a + N_B_GROUPS * B_WIDTH
    c_k = c_q + B_WIDTH
    for l in range(DEPTH):
        h = rms_norm(x, mix_norm[l])
        z = h @ w_in[l]
        a_out = chunked_spatial_gating(z[..., :c_a], a_ln_g[l], a_ln_b[l], a_w_s[l], a_b_s[l])
        b_out = dilated_attention(z[..., c_a:c_q], z[..., c_q:c_k], z[..., c_k:],
                                  cos, sin, q_norm[l], k_norm[l])
        mixed = jnp.concatenate([rms_norm(a_out, a_out_norm[l]),
                                 rms_norm(b_out, b_out_norm[l])], axis=-1)
        x = x + mixed @ w_out[l]
        h = rms_norm(x, ffn_norm[l])
        x = x + (jax.nn.silu(h @ w_gate[l]) * (h @ w_up[l])) @ w_down[l]
    return x
```

```cpp
#include <hip/hip_runtime.h>
#include <hip/hip_bf16.h>
#include <hip/hip_cooperative_groups.h>
#include <cstdio>
#include <cstdint>
namespace cg = cooperative_groups;
__device__ __forceinline__ int ltid() { int t = threadIdx.x; asm volatile("" : "+v"(t)); return t; }
namespace pg8 {
#define PG8_LAS __attribute__((address_space(3)))
typedef unsigned short bf16_t;
typedef short bf16x8 __attribute__((ext_vector_type(8)));
typedef float f32x4 __attribute__((ext_vector_type(4)));
typedef unsigned u32x4 __attribute__((ext_vector_type(4)));
constexpr int BM = 256, BK = 64, HALF = 128, HTB = HALF * BK * 2  , STAGE_BYTES = 8 * HTB, NXCD = 8, WGM = 8;

__host__ __device__ __forceinline__ int lds_byte(int r, int c) { const int st = (r >> 4) * 2 + (c >> 5), rr = r & 15, cc = c & 31, ob = rr * 64 + cc * 2; return st * 1024 + (ob ^ (((ob >> 9) & 1) << 5)); }
__host__ __device__ __forceinline__ void stage_rc(int b, int& R, int& C) { const int st = b / 1024, sb = b % 1024, swz = sb ^ (((sb >> 9) & 1) << 5); R = (st >> 1) * 16 + swz / 64; C = (st & 1) * 32 + (swz % 64) / 2; }
__host__ __device__ __forceinline__ int perm32(int rho) { const int n = rho >> 4, i = rho & 15; return 8 * (i >> 2) + 4 * n + (i & 3); }

struct Unit { int pm, pn; };
struct Gemm { const bf16_t* A; const bf16_t* Bt; int M, N, K, lda; };

struct StaticOrder {
    int nM, nN, nwg, G, c;
    __host__ __device__ void init(int M, int N, int G_, int c_) { nM = M / BM; nN = N / BM; nwg = nM * nN; G = G_; c = c_; }
    __host__ __device__ bool next(int i, Unit& u) const {
        const long L = (long)i * G + c; if (L >= nwg) return false;
        int wgid = (int)L; { const int q = nwg / NXCD, r = nwg % NXCD, xcd = wgid % NXCD, off = wgid / NXCD; wgid = (xcd < r ? xcd * (q + 1) : r * (q + 1) + (xcd - r) * q) + off; }
        const int nig = WGM * nN, gid = wgid / nig, fm = gid * WGM, gsz = (nM - fm) < WGM ? (nM - fm) : WGM;
        u.pm = fm + ((wgid % nig) % gsz); u.pn = (wgid % nig) / gsz; return true;
    }
    __device__ __forceinline__ void a_ready(const Unit&) const {}
    __device__ __forceinline__ void done(const Unit&) const {}
};

__device__ __forceinline__ unsigned cvt_pk_bf16(float lo, float hi) { unsigned r; asm volatile("v_cvt_pk_bf16_f32 %0, %1, %2" : "=v"(r) : "v"(lo), "v"(hi)); return r; }
typedef float f32x2 __attribute__((ext_vector_type(2)));
__device__ __forceinline__ f32x2 gelu_pk(f32x2 v) {
    const f32x2 av = __builtin_elementwise_abs(v), d = av * 0.2316418882f + 1.0f;
    f32x2 t; t.x = __builtin_amdgcn_rcpf(d.x); t.y = __builtin_amdgcn_rcpf(d.y);
    f32x2 q = t * 0.5307027145f + (-0.7265760135f); q = q * t + 0.7107068705f; q = q * t + (-0.142248368f); q = q * t + 0.127414796f; q = q * t;
    const f32x2 s = (v * v) * (-0.72134752044f);
    f32x2 e; e.x = __builtin_amdgcn_exp2f(s.x); e.y = __builtin_amdgcn_exp2f(s.y);
    const f32x2 m = v * (q * e), r = v - m;
    f32x2 o; o.x = v.x < 0.f ? m.x : r.x; o.y = v.y < 0.f ? m.y : r.y; return o;
}
typedef unsigned u32x2 __attribute__((ext_vector_type(2)));
struct RowScale {
    const float* rsq; int nparts; int mtot; PG8_LAS float* tab;
    __device__ __forceinline__ int begin(const Unit& u) const {
        const int t = ltid();
        if (t < BM) { float v[8];
#pragma unroll
            for (int p = 0; p < 8; ++p) v[p] = rsq[(size_t)(p < nparts ? p : 0) * mtot + u.pm * BM + t];
            float s = v[0];
#pragma unroll
            for (int p = 1; p < 8; ++p) s += (p < nparts) ? v[p] : 0.f;
            tab[t] = s; }
        asm volatile("s_waitcnt lgkmcnt(0)\n\ts_barrier" ::: "memory");
        return u.pm;
    }
    __device__ __forceinline__ void preload(const Unit&, int, int wr, int fr, float (&pre)[8]) const {
#pragma unroll
        for (int i = 0; i < 8; ++i) pre[i] = tab[wr * 64 + fr + (i >> 2) * HALF + (i & 3) * 16];
    }
};
__device__ __forceinline__ float silu_f(float x) { return x * __builtin_amdgcn_rcpf(1.0f + __builtin_amdgcn_exp2f(-1.4426950408889634f * x)); }
struct EpiZ {
    static constexpr bool PERM = true, AFTER_DRAIN = false;
    bf16_t* O; int ldc; RowScale rsc; const float* qg; const float* kg; const float* rope; PG8_LAS float* xl;
    __device__ __forceinline__ int begin(const Unit& u) const { return rsc.begin(u); }
    __device__ __forceinline__ void preload(const Unit& u, int tab_pm, int wr, int fr, float (&pre)[8]) const { rsc.preload(u, tab_pm, wr, fr, pre); }
    __device__ __forceinline__ void operator()(const f32x4 (&acc)[2][2][4][2], const Unit& u, int wr, int wc, int fr, int fq, const float (&pre)[8]) const {
        const int row0 = u.pm * BM + wr * 64 + fr; const int col0 = u.pn * BM + wc * 32 + 8 * fq;
        if (u.pn >= 8 && u.pn < 24) {
            float rsv[2][4];
            u32x4 csv[2][4];
#pragma unroll
            for (int ai = 0; ai < 2; ++ai)
#pragma unroll
                for (int m = 0; m < 4; ++m) csv[ai][m] = *(const u32x4*)((const unsigned*)rope + (size_t)((row0 + ai * HALF + m * 16) & 4095) * 64 + 16 * wc + 4 * fq);
            asm volatile("" ::: "memory");
#pragma unroll
            for (int ai = 0; ai < 2; ++ai)
#pragma unroll
                for (int m = 0; m < 4; ++m) { const float rs = __builtin_amdgcn_rsqf(pre[ai * 4 + m] * (1.f / 2048.f) + 1e-6f); rsv[ai][m] = rs;
#pragma unroll
                    for (int bj = 0; bj < 2; ++bj) { const f32x4 a = acc[ai][bj][m][0] * rs, b = acc[ai][bj][m][1] * rs;
                        float ss = ((a[0] * a[0] + a[1] * a[1]) + (a[2] * a[2] + a[3] * a[3])) + ((b[0] * b[0] + b[1] * b[1]) + (b[2] * b[2] + b[3] * b[3]));
                        ss += __shfl_xor(ss, 16); ss += __shfl_xor(ss, 32);
                        if (fq == 0) xl[((ai * HALF + wr * 64 + m * 16 + fr) * 2 + bj) * 4 + wc] = ss; } }
            const float* gn = (u.pn < 20 ? qg : kg) + 16 * wc + 4 * fq;
            const f32x4 g1 = *(const f32x4*)gn, g2 = *(const f32x4*)(gn + 64);
            asm volatile("s_waitcnt lgkmcnt(0)\n\ts_barrier" ::: "memory");
#pragma unroll
            for (int ai = 0; ai < 2; ++ai)
#pragma unroll
                for (int m = 0; m < 4; ++m) { const int row = row0 + ai * HALF + m * 16; bf16_t* rowp = O + (size_t)row * ldc + col0; const float rs = rsv[ai][m];
                    const u32x4 cw = csv[ai][m]; const f32x4 cs = {__builtin_bit_cast(float, cw.x << 16), __builtin_bit_cast(float, cw.y << 16), __builtin_bit_cast(float, cw.z << 16), __builtin_bit_cast(float, cw.w << 16)},
                        sn = {__builtin_bit_cast(float, cw.x & 0xffff0000u), __builtin_bit_cast(float, cw.y & 0xffff0000u), __builtin_bit_cast(float, cw.z & 0xffff0000u), __builtin_bit_cast(float, cw.w & 0xffff0000u)};
#pragma unroll
                    for (int bj = 0; bj < 2; ++bj) { const f32x4 p = *(const PG8_LAS f32x4*)(xl + ((ai * HALF + wr * 64 + m * 16 + fr) * 2 + bj) * 4);
                        const float rh = rs * __builtin_amdgcn_rsqf(((p[0] + p[1]) + (p[2] + p[3])) * (1.f / 128.f) + 1e-6f);
                        const f32x4 y1 = acc[ai][bj][m][0] * rh * g1, y2 = acc[ai][bj][m][1] * rh * g2;
                        const f32x4 o1 = y1 * cs - y2 * sn, o2 = y2 * cs + y1 * sn;
                        u32x4 w; w.x = cvt_pk_bf16(o1[0], o1[1]); w.y = cvt_pk_bf16(o1[2], o1[3]); w.z = cvt_pk_bf16(o2[0], o2[1]); w.w = cvt_pk_bf16(o2[2], o2[3]);
                        *(u32x4*)(rowp + bj * HALF) = w; } }
            return;
        }
        const bool act = u.pn < 8;
#pragma unroll
        for (int ai = 0; ai < 2; ++ai)
#pragma unroll
            for (int m = 0; m < 4; ++m) { bf16_t* rowp = O + (size_t)(row0 + ai * HALF + m * 16) * ldc + col0;
                const float rs = __builtin_amdgcn_rsqf(pre[ai * 4 + m] * (1.f / 2048.f) + 1e-6f);
#pragma unroll
                for (int bj = 0; bj < 2; ++bj) { f32x4 v0 = acc[ai][bj][m][0] * rs, v1 = acc[ai][bj][m][1] * rs;
                    if (act) { f32x2 a = gelu_pk((f32x2){v0[0], v0[1]}), b = gelu_pk((f32x2){v0[2], v0[3]}), c = gelu_pk((f32x2){v1[0], v1[1]}), d = gelu_pk((f32x2){v1[2], v1[3]});
                        v0 = (f32x4){a.x, a.y, b.x, b.y}; v1 = (f32x4){c.x, c.y, d.x, d.y}; }
                    u32x4 w; w.x = cvt_pk_bf16(v0[0], v0[1]); w.y = cvt_pk_bf16(v0[2], v0[3]); w.z = cvt_pk_bf16(v1[0], v1[1]); w.w = cvt_pk_bf16(v1[2], v1[3]);
                    *(u32x4*)(rowp + bj * HALF) = w; } }
    }
};
struct EpiRes {
    static constexpr bool PERM = true, AFTER_DRAIN = false;
    bf16_t* xb; float* outf; int ldc; float* rsq_out; int mtot; PG8_LAS float* xl;
    __device__ __forceinline__ int begin(const Unit& u) const { return u.pm; }
    __device__ __forceinline__ void preload(const Unit&, int, int, int, float (&pre)[8]) const {
#pragma unroll
        for (int i = 0; i < 8; ++i) pre[i] = 0.f;
    }
    __device__ __forceinline__ void operator()(const f32x4 (&acc)[2][2][4][2], const Unit& u, int wr, int wc, int fr, int fq, const float (&)[8]) const {
        const int col0 = u.pn * BM + wc * 32 + 8 * fq;
        u32x4 bx[2][4][2];
#pragma unroll
        for (int ai = 0; ai < 2; ++ai)
#pragma unroll
            for (int m = 0; m < 4; ++m)
#pragma unroll
                for (int bj = 0; bj < 2; ++bj) bx[ai][m][bj] = *(const u32x4*)(xb + (size_t)(u.pm * BM + ai * HALF + wr * 64 + m * 16 + fr) * ldc + col0 + bj * HALF);
        asm volatile("" ::: "memory");
#pragma unroll
        for (int ai = 0; ai < 2; ++ai)
#pragma unroll
            for (int m = 0; m < 4; ++m) { const int rl = ai * HALF + wr * 64 + m * 16 + fr; const size_t off = (size_t)(u.pm * BM + rl) * ldc + col0;
                float ss = 0.f;
#pragma unroll
                for (int bj = 0; bj < 2; ++bj) { const u32x4 b = bx[ai][m][bj];
                    f32x4 o0, o1;
                    o0[0] = __builtin_bit_cast(float, b.x << 16) + acc[ai][bj][m][0][0]; o0[1] = __builtin_bit_cast(float, b.x & 0xffff0000u) + acc[ai][bj][m][0][1];
                    o0[2] = __builtin_bit_cast(float, b.y << 16) + acc[ai][bj][m][0][2]; o0[3] = __builtin_bit_cast(float, b.y & 0xffff0000u) + acc[ai][bj][m][0][3];
                    o1[0] = __builtin_bit_cast(float, b.z << 16) + acc[ai][bj][m][1][0]; o1[1] = __builtin_bit_cast(float, b.z & 0xffff0000u) + acc[ai][bj][m][1][1];
                    o1[2] = __builtin_bit_cast(float, b.w << 16) + acc[ai][bj][m][1][2]; o1[3] = __builtin_bit_cast(float, b.w & 0xffff0000u) + acc[ai][bj][m][1][3];
                    if (outf) { *(f32x4*)(outf + off + bj * HALF) = o0; *(f32x4*)(outf + off + bj * HALF + 4) = o1; }
                    else { ss += ((o0[0] * o0[0] + o0[1] * o0[1]) + (o0[2] * o0[2] + o0[3] * o0[3])) + ((o1[0] * o1[0] + o1[1] * o1[1]) + (o1[2] * o1[2] + o1[3] * o1[3]));
                        u32x4 w; w.x = cvt_pk_bf16(o0[0], o0[1]); w.y = cvt_pk_bf16(o0[2], o0[3]); w.z = cvt_pk_bf16(o1[0], o1[1]); w.w = cvt_pk_bf16(o1[2], o1[3]); *(u32x4*)(xb + off + bj * HALF) = w; } }
                if (rsq_out) { ss += __shfl_xor(ss, 16); ss += __shfl_xor(ss, 32); if (fq == 0) xl[rl * 4 + wc] = ss; } }
        if (rsq_out) {
            asm volatile("s_waitcnt lgkmcnt(0)\n\ts_barrier" ::: "memory");
            const int t = ltid();
            if (t < BM) { const f32x4 p = *(const PG8_LAS f32x4*)(xl + 4 * t); rsq_out[(size_t)u.pn * mtot + u.pm * BM + t] = (p[0] + p[1]) + (p[2] + p[3]); }
        }
    }
};
struct EpiSwiGLU {
    static constexpr bool PERM = true, AFTER_DRAIN = false;
    bf16_t* O; int ldc; RowScale rsc;
    __device__ __forceinline__ int begin(const Unit& u) const { return rsc.begin(u); }
    __device__ __forceinline__ void preload(const Unit& u, int tab_pm, int wr, int fr, float (&pre)[8]) const { rsc.preload(u, tab_pm, wr, fr, pre); }
    __device__ __forceinline__ void operator()(const f32x4 (&acc)[2][2][4][2], const Unit& u, int wr, int wc, int fr, int fq, const float (&pre)[8]) const {
        const int row0 = u.pm * BM + wr * 64 + fr; const int col0 = u.pn * HALF + wc * 32 + 8 * fq;
#pragma unroll
        for (int ai = 0; ai < 2; ++ai)
#pragma unroll
            for (int m = 0; m < 4; ++m) { bf16_t* rowp = O + (size_t)(row0 + ai * HALF + m * 16) * ldc + col0;
                const float rs = __builtin_amdgcn_rsqf(pre[ai * 4 + m] * (1.f / 2048.f) + 1e-6f);
                const f32x4 g0 = acc[ai][0][m][0] * rs, g1 = acc[ai][0][m][1] * rs, u0 = acc[ai][1][m][0] * rs, u1 = acc[ai][1][m][1] * rs;
                u32x4 w; w.x = cvt_pk_bf16(silu_f(g0[0]) * u0[0], silu_f(g0[1]) * u0[1]); w.y = cvt_pk_bf16(silu_f(g0[2]) * u0[2], silu_f(g0[3]) * u0[3]);
                w.z = cvt_pk_bf16(silu_f(g1[0]) * u1[0], silu_f(g1[1]) * u1[1]); w.w = cvt_pk_bf16(silu_f(g1[2]) * u1[2], silu_f(g1[3]) * u1[3]);
                *(u32x4*)rowp = w; }
    }
};
template <class Epi, class Sched, bool ALIGN_EPI = false, bool SP2 = false>
__device__ __forceinline__ void gemm_phase(PG8_LAS unsigned char* lds, const Gemm g, const Sched& S, const Epi& E) {
    const int tid = ltid(), wid = __builtin_amdgcn_readfirstlane(tid >> 6), lane = tid & 63, wr = wid >> 2, wc = wid & 3, fr = lane & 15, fq = lane >> 4;
    const int K = g.K, nt = K / BK;
    unsigned voffA[2], voffB[2];
#pragma unroll
    for (int i = 0; i < 2; ++i) { int R, C; stage_rc(tid * 16 + i * 8192, R, C); const int Rb = Epi::PERM ? ((R & ~31) + perm32(R & 31)) : R;
        voffA[i] = (unsigned)(R * g.lda + C) * 2u; voffB[i] = (unsigned)(Rb * K + C) * 2u; }
    const size_t kstep = (size_t)(BK * 2);
    const size_t hstep = (size_t)HALF * K * 2;
    const size_t tstep = 2 * hstep;
    const size_t hstepA = (size_t)HALF * g.lda * 2, tstepA = 2 * hstepA;
    const unsigned ldsw = (unsigned)wid * 1024u;
    const int aoff = lds_byte(wr * 64 + fr, fq * 8), boff = lds_byte(wc * 32 + fr, fq * 8);
#define PG8_SA(b, h) (((b) * 2 + (h)) * HTB)
#define PG8_SB(b, h) ((4 + (b) * 2 + (h)) * HTB)
#define PG8_STAGE(bufoff, gbase, voff) do { _Pragma("unroll") for (int _i = 0; _i < 2; ++_i) \
        __builtin_amdgcn_global_load_lds((const unsigned*)((const char*)(gbase) + (voff)[_i]), (PG8_LAS unsigned*)(lds + (bufoff) + ldsw + _i * 8192), 16, 0, 0); } while (0)
#define PG8_LDA(dst, b, h) do { _Pragma("unroll") for (int m = 0; m < 4; ++m) _Pragma("unroll") for (int k = 0; k < 2; ++k) dst[m][k] = *(const PG8_LAS bf16x8*)(lds + PG8_SA(b, h) + aoff + m * 2048 + k * 1024); } while (0)
#define PG8_LDB(dst, b, h) do { _Pragma("unroll") for (int n = 0; n < 2; ++n) _Pragma("unroll") for (int k = 0; k < 2; ++k) dst[n][k] = *(const PG8_LAS bf16x8*)(lds + PG8_SB(b, h) + boff + n * 2048 + k * 1024); } while (0)
#define PG8_MMA(ai, bj, At, Bt) do { __builtin_amdgcn_s_setprio(1); _Pragma("unroll") for (int m = 0; m < 4; ++m) _Pragma("unroll") for (int n = 0; n < 2; ++n) _Pragma("unroll") for (int k = 0; k < 2; ++k) \
        acc[ai][bj][m][n] = __builtin_amdgcn_mfma_f32_16x16x32_bf16(Bt[n][k], At[m][k], acc[ai][bj][m][n], 0, 0, 0); __builtin_amdgcn_s_setprio(0); } while (0)
#define PG8_WAIT_V(n) asm volatile("s_waitcnt vmcnt(" #n ")" ::: "memory")
#define PG8_WAIT_L(n) asm volatile("s_waitcnt lgkmcnt(" #n ")" ::: "memory")
#define PG8_BAR __builtin_amdgcn_s_barrier()
#define PG8_SCHED __builtin_amdgcn_sched_barrier(0)
    Unit cur, nxt; int ui = 0;
    if (!S.next(0, cur)) return;
    float pre[8], preN[8];
    const int tab_pm = E.begin(cur);
    E.preload(cur, tab_pm, wr, fr, pre);
    f32x4 acc[2][2][4][2];
#pragma unroll
    for (int a = 0; a < 2; ++a)
#pragma unroll
        for (int b = 0; b < 2; ++b)
#pragma unroll
            for (int m = 0; m < 4; ++m)
#pragma unroll
                for (int n = 0; n < 2; ++n) acc[a][b][m][n] = (f32x4){0.f, 0.f, 0.f, 0.f};
    bf16x8 At[4][2], B0[2][2], B1[2][2];
    const char* cA = (const char*)g.A + (size_t)cur.pm * tstepA; const char* cB = (const char*)g.Bt + (size_t)cur.pn * tstep;
    S.a_ready(cur);
    if constexpr (SP2) {
        PG8_STAGE(PG8_SB(0, 0), cB, voffB); PG8_STAGE(PG8_SB(0, 1), cB + hstep, voffB); PG8_STAGE(PG8_SA(0, 0), cA, voffA); PG8_STAGE(PG8_SA(0, 1), cA + hstepA, voffA);
        if (wr == 1) PG8_BAR;
        PG8_WAIT_V(2); PG8_BAR;
        PG8_STAGE(PG8_SB(1, 0), cB + kstep, voffB); PG8_STAGE(PG8_SA(1, 0), cA + kstep, voffA); PG8_STAGE(PG8_SB(1, 1), cB + hstep + kstep, voffB);
        PG8_WAIT_V(6); PG8_BAR;
    } else {
        PG8_STAGE(PG8_SB(0, 0), cB, voffB); PG8_STAGE(PG8_SA(0, 0), cA, voffA); PG8_STAGE(PG8_SB(0, 1), cB + hstep, voffB); PG8_STAGE(PG8_SA(0, 1), cA + hstepA, voffA);
        if (wr == 1) PG8_BAR;
        PG8_WAIT_V(4); PG8_BAR;
        PG8_STAGE(PG8_SB(1, 0), cB + kstep, voffB); PG8_STAGE(PG8_SA(1, 0), cA + kstep, voffA); PG8_STAGE(PG8_SB(1, 1), cB + hstep + kstep, voffB);
        PG8_WAIT_V(6); PG8_BAR;
    }
    for (;;) {
        const bool has_next = S.next(ui + 1, nxt);
        const char* nA = has_next ? (const char*)g.A + (size_t)nxt.pm * tstepA : cA; const char* nB = has_next ? (const char*)g.Bt + (size_t)nxt.pn * tstep : cB;
        for (int t = 0; t < nt; t += 2) {
            const bool last = (t == nt - 2);
            const char* a1 = cA + (size_t)(t + 1) * kstep;
            const char* a2 = last ? nA : cA + (size_t)(t + 2) * kstep; const char* b2 = last ? nB : cB + (size_t)(t + 2) * kstep;
            const char* a3 = a2 + kstep; const char* b3 = b2 + kstep;
            if (last && has_next) S.a_ready(nxt);
            if constexpr (SP2) {
            PG8_LDB(B0, 0, 0); PG8_LDB(B1, 0, 1); PG8_SCHED; PG8_LDA(At, 0, 0); PG8_STAGE(PG8_SA(1, 1), a1 + hstepA, voffA);
            PG8_WAIT_V(8); PG8_WAIT_L(0); PG8_BAR; PG8_MMA(0, 0, At, B0); PG8_MMA(0, 1, At, B1); PG8_BAR; PG8_SCHED;
            PG8_LDA(At, 0, 1); PG8_STAGE(PG8_SB(0, 0), b2, voffB); PG8_STAGE(PG8_SB(0, 1), b2 + hstep, voffB); PG8_STAGE(PG8_SA(0, 0), a2, voffA);
            PG8_WAIT_V(8); PG8_WAIT_L(0); PG8_BAR; PG8_MMA(1, 0, At, B0); PG8_MMA(1, 1, At, B1); PG8_BAR; PG8_SCHED;
            PG8_LDB(B0, 1, 0); PG8_LDB(B1, 1, 1); PG8_SCHED; PG8_LDA(At, 1, 0); PG8_STAGE(PG8_SA(0, 1), a2 + hstepA, voffA);
            PG8_WAIT_V(8); PG8_WAIT_L(0); PG8_BAR; PG8_MMA(0, 0, At, B0); PG8_MMA(0, 1, At, B1); PG8_BAR; PG8_SCHED;
            PG8_LDA(At, 1, 1); PG8_STAGE(PG8_SB(1, 0), b3, voffB); PG8_STAGE(PG8_SB(1, 1), b3 + hstep, voffB); PG8_STAGE(PG8_SA(1, 0), a3, voffA);
            PG8_WAIT_V(8); PG8_WAIT_L(0); PG8_BAR; PG8_MMA(1, 0, At, B0); PG8_MMA(1, 1, At, B1); PG8_BAR; PG8_SCHED;
            } else {
            PG8_LDB(B0, 0, 0); PG8_SCHED; PG8_LDA(At, 0, 0); PG8_STAGE(PG8_SA(1, 1), a1 + hstepA, voffA);
            PG8_WAIT_L(8); PG8_BAR; PG8_WAIT_L(0); PG8_MMA(0, 0, At, B0); PG8_BAR; PG8_SCHED;
            PG8_LDB(B1, 0, 1); PG8_STAGE(PG8_SB(0, 0), b2, voffB);
            PG8_BAR; PG8_WAIT_L(0); PG8_MMA(0, 1, At, B1); PG8_BAR;
            PG8_LDA(At, 0, 1); PG8_STAGE(PG8_SA(0, 0), a2, voffA);
            PG8_BAR; PG8_WAIT_L(0); PG8_MMA(1, 0, At, B0); PG8_BAR; PG8_SCHED;
            PG8_STAGE(PG8_SB(0, 1), b2 + hstep, voffB);
            PG8_WAIT_V(6); PG8_BAR; PG8_MMA(1, 1, At, B1); PG8_BAR;
            PG8_LDB(B0, 1, 0); PG8_SCHED; PG8_LDA(At, 1, 0); PG8_STAGE(PG8_SA(0, 1), a2 + hstepA, voffA);
            PG8_WAIT_L(8); PG8_BAR; PG8_WAIT_L(0); PG8_MMA(0, 0, At, B0); PG8_BAR; PG8_SCHED;
            PG8_LDB(B1, 1, 1); PG8_STAGE(PG8_SB(1, 0), b3, voffB);
            PG8_BAR; PG8_WAIT_L(0); PG8_MMA(0, 1, At, B1); PG8_BAR;
            PG8_LDA(At, 1, 1); PG8_STAGE(PG8_SA(1, 0), a3, voffA);
            PG8_BAR; PG8_WAIT_L(0); PG8_MMA(1, 0, At, B0); PG8_BAR; PG8_SCHED;
            PG8_STAGE(PG8_SB(1, 1), b3 + hstep, voffB);
            PG8_WAIT_V(6); PG8_BAR; PG8_MMA(1, 1, At, B1); PG8_BAR;
            }
        }
        if constexpr (ALIGN_EPI) { if (wr == 0) PG8_BAR; }
        if (has_next) E.preload(nxt, tab_pm, wr, fr, preN);
        if constexpr (!Epi::AFTER_DRAIN) { E(acc, cur, wr, wc, fr, fq, pre); S.done(cur); }
#pragma unroll
        for (int i_ = 0; i_ < 8; ++i_) pre[i_] = preN[i_];
        if (!has_next) break;
#pragma unroll
        for (int a = 0; a < 2; ++a)
#pragma unroll
            for (int b = 0; b < 2; ++b)
#pragma unroll
                for (int m = 0; m < 4; ++m)
#pragma unroll
                    for (int n = 0; n < 2; ++n) acc[a][b][m][n] = (f32x4){0.f, 0.f, 0.f, 0.f};
        cur = nxt; cA = nA; cB = nB; ++ui;
        if constexpr (ALIGN_EPI) { if (wr == 1) PG8_BAR; }
    }
    PG8_WAIT_V(0);
    if constexpr (!ALIGN_EPI) { if (wr == 0) PG8_BAR; }
    PG8_BAR;
    if constexpr (Epi::AFTER_DRAIN) { E.fused(acc, cur, wr, wc, fr, fq, lds, wid, lane); S.done(cur); }
#undef PG8_SA
#undef PG8_SB
#undef PG8_STAGE
#undef PG8_LDA
#undef PG8_LDB
#undef PG8_MMA
#undef PG8_WAIT_V
#undef PG8_WAIT_L
#undef PG8_BAR
#undef PG8_SCHED
}
}
namespace swa {
constexpr int D = 128;
constexpr float THR = 8.f;
constexpr bool WSKIP = true;
constexpr float SCALE = 0.08838834764831845f;
constexpr int NW = 8, QBLK = 32, KVBLK = 64, QB = NW * QBLK;
constexpr int SHM_V = KVBLK * D * 2, SHM_K = KVBLK * D * 2;
constexpr int LDS_BYTES = 2 * SHM_V + 2 * SHM_K + NW * 64 * 4;
using bf16 = __hip_bfloat16;
typedef short bf16x8 __attribute__((ext_vector_type(8)));
typedef short s16x4 __attribute__((ext_vector_type(4)));
typedef float f32x16 __attribute__((ext_vector_type(16)));
typedef float f32x4 __attribute__((ext_vector_type(4)));
typedef unsigned u32x4 __attribute__((ext_vector_type(4)));
template <class A, class Bt> struct same_t { static constexpr bool v = false; };
template <class A> struct same_t<A, A> { static constexpr bool v = true; };

#define KSWZ(row, colB) ((row) * 256 + ((colB) ^ (((row) & 7) << 4)))
#define SBAR() __builtin_amdgcn_sched_barrier(0)
__device__ __forceinline__ int v_st(int k, int c) { const int kk = (k & ~0xC) | ((k & 4) << 1) | ((k & 8) >> 1); return ((kk >> 3) * 4 + (c >> 5)) * 512 + ((kk & 7) * 32 + (c & 31)) * 2; }
__device__ __forceinline__ int v_rd_base(int lane) { return ((lane & 3) << 3) | (((lane >> 2) & 3) << 6) | (((lane >> 4) & 1) << 5) | (((lane >> 5) & 1) << 8); }
constexpr int v_rd_off(int d0, int ks, int half) { return d0 * 512 + ks * 4096 + half * 2048; }
__device__ __forceinline__ int crow(int r, int hi) { return (r & 3) + 8 * (r >> 2) + 4 * hi; }
__device__ __forceinline__ unsigned cvtpk(float lo, float hi) {
    unsigned r; asm volatile("v_cvt_pk_bf16_f32 %0, %1, %2" : "=v"(r) : "v"(lo), "v"(hi)); return r;
}
__device__ __forceinline__ bf16x8 pack8(f32x4 a, f32x4 b) {
    u32x4 w = {cvtpk(a[0], a[1]), cvtpk(a[2], a[3]), cvtpk(b[0], b[1]), cvtpk(b[2], b[3])};
    return *reinterpret_cast<bf16x8*>(&w);
}
template <class T> __device__ __forceinline__ bf16x8 load8(const T* p) {
    if constexpr (same_t<T, float>::v) { return pack8(*(const f32x4*)p, *(const f32x4*)(p + 4)); }
    else { return *reinterpret_cast<const bf16x8*>(p); }
}
__device__ __forceinline__ void mask_tile(f32x16& p0, f32x16& p1, int dq, unsigned W) {
    const float NEG = -__builtin_inff();
#pragma unroll
    for (int r = 0; r < 16; ++r) {
        const int c = (r & 3) + 8 * (r >> 2);
        if ((unsigned)(dq - c) >= W) p0[r] = NEG;
        if ((unsigned)(dq - c - 32) >= W) p1[r] = NEG;
    }
}
__device__ __forceinline__ void partialSM(f32x16& p0, f32x16& p1, float& m_reg, float& mn, float& alpha) {
    float pmax = p0[0]; for (int r = 1; r < 16; ++r) pmax = fmaxf(pmax, p0[r]); for (int r = 0; r < 16; ++r) pmax = fmaxf(pmax, p1[r]);
    { auto rr = __builtin_amdgcn_permlane32_swap(__float_as_uint(pmax), __float_as_uint(pmax), false, false);
      pmax = fmaxf(__uint_as_float(rr[0]), __uint_as_float(rr[1])); }
    constexpr float C2 = 1.4426950408889634f * SCALE;
    if (__builtin_expect(__all((pmax - m_reg) * SCALE <= THR), 1)) { mn = m_reg; alpha = 1.f; }
    else { mn = fmaxf(m_reg, pmax); alpha = __builtin_amdgcn_exp2f((m_reg - mn) * C2); m_reg = mn; }
    const float mnL = -mn * C2;
    for (int r = 0; r < 16; ++r) p0[r] = fmaf(p0[r], C2, mnL); for (int r = 0; r < 16; ++r) p1[r] = fmaf(p1[r], C2, mnL);
    for (int r = 0; r < 16; ++r) p0[r] = __builtin_amdgcn_exp2f(p0[r]);
}
__device__ __forceinline__ void finishSM(f32x16& p0, f32x16& p1, float alpha, float& l_reg, bf16x8& pa0, bf16x8& pa1, bf16x8& pa2, bf16x8& pa3) {
    for (int r = 0; r < 16; ++r) p1[r] = __builtin_amdgcn_exp2f(p1[r]);
    float ps = 0; for (int r = 0; r < 16; ++r) ps += p0[r]; for (int r = 0; r < 16; ++r) ps += p1[r];
    { auto rr = __builtin_amdgcn_permlane32_swap(__float_as_uint(ps), __float_as_uint(ps), false, false);
      ps = __uint_as_float(rr[0]) + __uint_as_float(rr[1]); }
    l_reg = l_reg * alpha + ps;
#define PK4(P, B_, OUT) do { unsigned a0 = cvtpk(P[B_+0], P[B_+1]), a1 = cvtpk(P[B_+2], P[B_+3]);                          \
        unsigned b0 = cvtpk(P[B_+4], P[B_+5]), b1 = cvtpk(P[B_+6], P[B_+7]);                                             \
        auto r0 = __builtin_amdgcn_permlane32_swap(a0, b0, false, false); auto r1 = __builtin_amdgcn_permlane32_swap(a1, b1, false, false); \
        u32x4 w = {r0[0], r1[0], r0[1], r1[1]}; OUT = *reinterpret_cast<bf16x8*>(&w); } while (0)
    PK4(p0, 0, pa0); PK4(p0, 8, pa1); PK4(p1, 0, pa2); PK4(p1, 8, pa3);
#undef PK4
}
template <int KB, bool SK>
__device__ __forceinline__ void qkt(f32x16& p0, f32x16& p1, const char* K_lds, int r32, int hi, const bf16x8* qr, bool act) {
    if (SK && !act) { const float NEG = -__builtin_inff();
#pragma unroll
        for (int r = 0; r < 16; ++r) { p0[r] = NEG; p1[r] = NEG; } return; }
    p0 = f32x16{}; p1 = f32x16{};
    const char* kb[4];
#pragma unroll
    for (int dd = 0; dd < 4; ++dd) kb[dd] = K_lds + KB * SHM_K + KSWZ(r32, (dd * 16 + hi * 8) * 2);
#pragma unroll
    for (int d0 = 0; d0 < 8; ++d0) { const char* a = kb[d0 & 3] + (d0 >> 2) * 128;
        bf16x8 b0 = *reinterpret_cast<const bf16x8*>(a);
        bf16x8 b1 = *reinterpret_cast<const bf16x8*>(a + 32 * 256);
        p0 = __builtin_amdgcn_mfma_f32_32x32x16_bf16(b0, qr[d0], p0, 0, 0, 0);
        p1 = __builtin_amdgcn_mfma_f32_32x32x16_bf16(b1, qr[d0], p1, 0, 0, 0); }
}
template <int VB, bool SK>
__device__ __forceinline__ void pv_tile(f32x16* o, int vb0, bf16x8 pa0, bf16x8 pa1, bf16x8 pa2, bf16x8 pa3, bool act) {
    if (SK && !act) return;
#define TRRD(dst, off) asm volatile("ds_read_b64_tr_b16 %0, %1 offset:%2" : "=&v"(dst) : "v"(vb0), "i"(off) : "memory")
#define PV_D0(d0) do { s16x4 l0, l1, l2, l3, h0, h1, h2, h3; constexpr int b_ = VB * SHM_V + v_rd_off(d0, 0, 0);     \
        TRRD(l0, b_); TRRD(h0, b_ + 2048); TRRD(l1, b_ + 4096); TRRD(h1, b_ + 6144); TRRD(l2, b_ + 8192); TRRD(h2, b_ + 10240); TRRD(l3, b_ + 12288); TRRD(h3, b_ + 14336); \
        asm volatile("s_waitcnt lgkmcnt(0)" ::: "memory"); SBAR();                 \
        o[d0] = __builtin_amdgcn_mfma_f32_32x32x16_bf16(pa0, (bf16x8){l0[0], l0[1], l0[2], l0[3], h0[0], h0[1], h0[2], h0[3]}, o[d0], 0, 0, 0);   \
        o[d0] = __builtin_amdgcn_mfma_f32_32x32x16_bf16(pa1, (bf16x8){l1[0], l1[1], l1[2], l1[3], h1[0], h1[1], h1[2], h1[3]}, o[d0], 0, 0, 0);   \
        o[d0] = __builtin_amdgcn_mfma_f32_32x32x16_bf16(pa2, (bf16x8){l2[0], l2[1], l2[2], l2[3], h2[0], h2[1], h2[2], h2[3]}, o[d0], 0, 0, 0);   \
        o[d0] = __builtin_amdgcn_mfma_f32_32x32x16_bf16(pa3, (bf16x8){l3[0], l3[1], l3[2], l3[3], h3[0], h3[1], h3[2], h3[3]}, o[d0], 0, 0, 0); } while (0)
    PV_D0(0); PV_D0(1); PV_D0(2); PV_D0(3);
#undef PV_D0
#undef TRRD
}

template <class TIn, class TOut> struct BlockRef { const TIn* Q; const TIn* K; const TIn* V; TOut* O; float* L; int P0; int pitch; int lpitch; };
template <class TIn> struct Seam {
    bf16x8 qr[8];
    bf16x8 st_v0, st_v1, st_k0, st_k1; f32x4 sf0, sf1, sf2, sf3;
    f32x4 tq[16];
};
__device__ __forceinline__ int swa_jlo(int P0, int W) { const int lowk = P0 - W + 1; return lowk > 0 ? lowk / KVBLK : 0; }
#define ROWP(p, k0, rr, pt) ((p) + (size_t)((k0) + (rr)) * (size_t)(pt) + sc)
#define ROW(p, k0, rr) ROWP(p, k0, rr, rowp_)
#define VMW() asm volatile("s_waitcnt vmcnt(0)" ::: "memory")
#define VMWN(n) asm volatile("s_waitcnt vmcnt(%0)" :: "i"(n) : "memory")
#define SLOAD_HP(Kp, Vp, k0, pt) do { S.st_v0 = load8<TIn>(ROWP(Vp, k0, sr, pt)); S.st_v1 = load8<TIn>(ROWP(Vp, k0, 32 + sr, pt));              \
                         S.st_k0 = load8<TIn>(ROWP(Kp, k0, sr, pt)); S.st_k1 = load8<TIn>(ROWP(Kp, k0, 32 + sr, pt)); } while (0)
#define SLOAD_H(Kp, Vp, k0) SLOAD_HP(Kp, Vp, k0, rowp_)
#define SWRITE_HK(bf) do { *(bf16x8*)(K_lds + (bf) * SHM_K + kws) = S.st_k0; *(bf16x8*)(K_lds + (bf) * SHM_K + kws + 32 * 256) = S.st_k1; } while (0)
#define SWRITE_HV(bf) do { *(bf16x8*)(V_lds + (bf) * SHM_V + vst0) = S.st_v0; *(bf16x8*)(V_lds + (bf) * SHM_V + vst1) = S.st_v1; } while (0)
#define SWRITE_H(bf) do { SWRITE_HV(bf); SWRITE_HK(bf); } while (0)
#define SLOAD_F(p, k0) do { S.sf0 = *(const f32x4*)ROW(p, k0, sr); S.sf1 = *(const f32x4*)(ROW(p, k0, sr) + 4);                \
                            S.sf2 = *(const f32x4*)ROW(p, k0, 32 + sr); S.sf3 = *(const f32x4*)(ROW(p, k0, 32 + sr) + 4); } while (0)
#define SWRITE_KF(bf) do { *(bf16x8*)(K_lds + (bf) * SHM_K + kws) = pack8(S.sf0, S.sf1); *(bf16x8*)(K_lds + (bf) * SHM_K + kws + 32 * 256) = pack8(S.sf2, S.sf3); } while (0)
#define SWRITE_VF(bf) do { *(bf16x8*)(V_lds + (bf) * SHM_V + vst0) = pack8(S.sf0, S.sf1); *(bf16x8*)(V_lds + (bf) * SHM_V + vst1) = pack8(S.sf2, S.sf3); } while (0)
template <class TIn, class TOut>
__device__ __forceinline__ void causal_swa_prime(const BlockRef<TIn, TOut>& cur, int W, char* lds, Seam<TIn>& S) {
    constexpr bool F32 = same_t<TIn, float>::v;
    const int tid = ltid(), wid = __builtin_amdgcn_readfirstlane(tid >> 6), lane = tid & 63, r32 = lane & 31, hi = lane >> 5;
    const int sr = tid >> 4, sc = (tid & 15) * 8, kws = KSWZ(sr, sc * 2); char* K_lds = lds + 2 * SHM_V;
    const int kb0 = swa_jlo(cur.P0, W) * KVBLK; const int rowp_ = cur.pitch;
    for (int d0 = 0; d0 < 8; ++d0) S.qr[d0] = load8<TIn>(cur.Q + (size_t)(wid * QBLK + r32) * (size_t)cur.pitch + d0 * 16 + hi * 8);
    if constexpr (F32) { SLOAD_F((const float*)cur.K, kb0); VMW(); SWRITE_KF(0); SBAR(); SLOAD_F((const float*)cur.V, kb0); }
    else { SLOAD_H(cur.K, cur.V, kb0); VMW(); SWRITE_HK(0); }
    __syncthreads();
}
template <class TIn, class TOut>
__device__ __forceinline__ void causal_swa_block(const BlockRef<TIn, TOut>& cur, const BlockRef<TIn, TOut>& nxt, int skv, int W, char* lds, Seam<TIn>& S) {
    constexpr bool F32 = same_t<TIn, float>::v;
    const int tid = ltid(), wid = __builtin_amdgcn_readfirstlane(tid >> 6), lane = tid & 63, r32 = lane & 31, hi = lane >> 5;
    const int j_lo = swa_jlo(cur.P0, W); const int rowp_ = cur.pitch;
    int j_hi = (cur.P0 + QB - 1) / KVBLK + 1; if (j_hi > skv / KVBLK) j_hi = skv / KVBLK;
    const int NT = j_hi - j_lo;
    const int kbn = swa_jlo(nxt.P0, W) * KVBLK;
    const int qlo = cur.P0 + wid * QBLK, qm = qlo + r32 - 4 * hi;
    char* V_lds = lds; char* K_lds = lds + 2 * SHM_V;
    float* ws = (float*)(lds + 2 * SHM_V + 2 * SHM_K) + wid * 64; float* li_l = ws, * al_l = ws + 32;
    float m_reg = -1e30f, l_reg = 0; f32x16 o[4] = {};
    const int sr = tid >> 4, sc = (tid & 15) * 8, vst0 = v_st(sr, sc), vst1 = v_st(32 + sr, sc), kws = KSWZ(sr, sc * 2);
    const int vb0 = (int)(uintptr_t)V_lds + v_rd_base(lane);
    const TIn* Kh = cur.K; const TIn* Vh = cur.V;
#define RESC(a) do { if (__any((a) < 1.f)) { if (hi == 0) al_l[r32] = (a); asm volatile("s_waitcnt lgkmcnt(0)" ::: "memory");              \
                     for (int d_ = 0; d_ < 4; ++d_) for (int r = 0; r < 16; ++r) o[d_][r] *= al_l[crow(r, hi)]; } } while (0)
#define KBASE(t) ((j_lo + (t)) * KVBLK)
#define ACT(t) (KBASE(t) <= qlo + QBLK - 1 && KBASE(t) + KVBLK - 1 >= qlo - W + 1)
#define MASKT(P0_, P1_, t) do { const int kb_ = KBASE(t); if ((!SK || ACT(t)) && (kb_ + KVBLK - 1 > qlo || kb_ <= qlo + QBLK - 1 - W)) mask_tile(P0_, P1_, qm - kb_, (unsigned)W); } while (0)
    constexpr int NQL = F32 ? 16 : 8;
    constexpr bool SK = WSKIP && !F32;
#define SEAM_K0() do { VMWN(NQL); if constexpr (F32) { SWRITE_KF(0); SBAR(); SLOAD_F((const float*)nxt.V, kbn); } else { SWRITE_HK(0); } SBAR(); } while (0)
    f32x16 pA0, pA1, pB0, pB1; float mnA, mnB, alA, alB; bf16x8 pa0, pa1, pa2, pa3;
    if constexpr (F32) { VMW(); SWRITE_VF(0); SBAR(); } else { SWRITE_HV(0); SBAR(); }
    if (NT > 1) { if constexpr (F32) SLOAD_F((const float*)Kh, KBASE(1)); else SLOAD_H(Kh, Vh, KBASE(1)); }
    SBAR(); qkt<0, SK>(pA0, pA1, K_lds, r32, hi, S.qr, ACT(0));
    if constexpr (F32) { if (NT > 1) { VMW(); SWRITE_KF(1); SBAR(); SLOAD_F((const float*)Vh, KBASE(1)); } }
    MASKT(pA0, pA1, 0); partialSM(pA0, pA1, m_reg, mnA, alA);
    if (NT > 1) { VMW(); if constexpr (F32) { SWRITE_VF(1); SBAR(); if (NT > 2) SLOAD_F((const float*)Kh, KBASE(2)); } else SWRITE_H(1); }
    __syncthreads();
#define HALF_STEP(PX0, PX1, mnX, alX, PY0, PY1, alY, t, KB, VB, SB) do {                                                      \
        SBAR(); qkt<KB, SK>(PX0, PX1, K_lds, r32, hi, S.qr, ACT(t));                                             \
        finishSM(PY0, PY1, alY, l_reg, pa0, pa1, pa2, pa3); SBAR();                                                           \
        if ((t) + 1 < NT) { if constexpr (F32) { VMW(); SWRITE_KF(SB); SBAR(); SLOAD_F((const float*)Vh, KBASE((t) + 1)); }  \
                            else { SLOAD_H(Kh, Vh, KBASE((t) + 1)); } SBAR(); }                                               \
        pv_tile<VB, SK>(o, vb0, pa0, pa1, pa2, pa3, ACT((t) - 1)); MASKT(PX0, PX1, (t)); partialSM(PX0, PX1, m_reg, mnX, alX);                                        \
        __syncthreads();                                                                                                      \
        if ((t) + 1 < NT) { VMW(); if constexpr (F32) { SWRITE_VF(SB); SBAR(); if ((t) + 2 < NT) SLOAD_F((const float*)Kh, KBASE((t) + 2)); } \
                            else { SWRITE_H(SB); } }                                                                          \
        RESC(alX); __syncthreads(); } while (0)
    for (int t = 1; t + 1 < NT; t += 2) {
        HALF_STEP(pB0, pB1, mnB, alB, pA0, pA1, alA, t, 1, 0, 0);
        HALF_STEP(pA0, pA1, mnA, alA, pB0, pB1, alB, t + 1, 0, 1, 1);
    }
    const bool even = (NT & 1) == 0;
    if (even) { SBAR(); qkt<1, SK>(pB0, pB1, K_lds, r32, hi, S.qr, ACT(NT - 1)); SBAR(); }
#define QROW(e) (nxt.Q + (size_t)(wid * QBLK + r32) * (size_t)nxt.pitch + ((e) >> 1) * 16 + hi * 8 + ((e) & 1) * 4)
    if constexpr (F32) { SLOAD_F((const float*)nxt.K, kbn); SBAR();
#pragma unroll
        for (int e = 0; e < 8; ++e) S.tq[e] = *(const f32x4*)QROW(e); }
    else { SLOAD_HP(nxt.K, nxt.V, kbn, nxt.pitch); SBAR();
#pragma unroll
        for (int d0 = 0; d0 < 8; ++d0) S.qr[d0] = load8<TIn>(nxt.Q + (size_t)(wid * QBLK + r32) * (size_t)nxt.pitch + d0 * 16 + hi * 8); }
    SBAR();
    finishSM(pA0, pA1, alA, l_reg, pa0, pa1, pa2, pa3); SBAR();
    if constexpr (F32) {
#pragma unroll
        for (int e = 8; e < 16; ++e) S.tq[e] = *(const f32x4*)QROW(e); SBAR(); }
#undef QROW
    pv_tile<0, SK>(o, vb0, pa0, pa1, pa2, pa3, ACT(even ? NT - 2 : NT - 1));
    if (even) { MASKT(pB0, pB1, NT - 1); partialSM(pB0, pB1, m_reg, mnB, alB); __syncthreads(); RESC(alB);
        finishSM(pB0, pB1, alB, l_reg, pa0, pa1, pa2, pa3); SBAR(); pv_tile<1, SK>(o, vb0, pa0, pa1, pa2, pa3, ACT(NT - 1)); }
    SBAR(); SEAM_K0();
    if (hi == 0) { li_l[r32] = l_reg; cur.L[(size_t)(wid * QBLK + r32) * (size_t)cur.lpitch] = m_reg * SCALE + __builtin_amdgcn_logf(l_reg) * 0.6931471805599453f; }
    asm volatile("s_waitcnt lgkmcnt(0)" ::: "memory");
    float rli[16];
#pragma unroll
    for (int r = 0; r < 16; ++r) rli[r] = __builtin_amdgcn_rcpf(li_l[crow(r, hi)]);
    TOut* Ow = cur.O + (size_t)(wid * QBLK) * (size_t)cur.pitch;
#pragma unroll
    for (int r = 0; r < 16; ++r) { const int orow = crow(r, hi);
#pragma unroll
        for (int d0 = 0; d0 < 4; ++d0) { const float v = o[d0][r] * rli[r];
            if constexpr (same_t<TOut, float>::v) { Ow[(size_t)orow * (size_t)cur.pitch + d0 * 32 + r32] = v; }
            else { const float vn = __shfl_xor(v, 1);
                   if ((r32 & 1) == 0) *(unsigned*)(Ow + (size_t)orow * (size_t)cur.pitch + d0 * 32 + r32) = cvtpk(v, vn); } } }
    if constexpr (F32) {
#pragma unroll
        for (int d0 = 0; d0 < 8; ++d0) S.qr[d0] = pack8(S.tq[2 * d0], S.tq[2 * d0 + 1]); }
    __syncthreads();
#undef RESC
#undef KBASE
#undef ACT
#undef MASKT
#undef SEAM_K0
#undef HALF_STEP
}
#undef ROW
#undef ROWP
#undef SLOAD_HP
#undef VMW
#undef VMWN
#undef SLOAD_H
#undef SWRITE_HK
#undef SWRITE_HV
#undef SWRITE_H
#undef SLOAD_F
#undef SWRITE_KF
#undef SWRITE_VF
}
#ifndef ONE_LAUNCH
#define ONE_LAUNCH 1
#endif
#ifndef PROBE_SKIP
#define PROBE_SKIP 0
#endif
#ifndef NPASS
#define NPASS 1
#endif
#ifndef PROBE_DUP_PROLOGUE
#define PROBE_DUP_PROLOGUE 0
#endif
constexpr int NBATCH = 4, SEQ = 4096, DM = 2048, M = NBATCH * SEQ, INW = 7168, DFF = 5632, DEPTH = 2;
constexpr int C_Q = 2048, C_K = 5120, C_V = 6144;
constexpr float EPS = 1e-6f;
constexpr int NWAVES = 8;
constexpr size_t MiB = 1u << 20;
constexpr size_t WS_CTL = 0, CTL_ZERO_BYTES = 1 * MiB;
constexpr int CW_BAR = 4096;
constexpr size_t WS_RSQ = 5 * MiB;
constexpr int RT_OFF = 131072 + 1024 + 8192;
constexpr int XL_OFF = 131072 + 1024;
constexpr int MISC_OFF = 131072 + 320;
constexpr size_t WS_ROPE = 1 * MiB;
constexpr size_t WS_LSE = 3 * MiB;
constexpr size_t WS_W = 8 * MiB;
constexpr size_t W_IN_OFF = 0, W_OUT_OFF = 28 * MiB, W_GU_OFF = 36 * MiB, W_DN_OFF = 80 * MiB, W_LAYER = 102 * MiB;
constexpr size_t WS_XN = WS_W + DEPTH * W_LAYER;
constexpr size_t WS_Z = WS_XN + 64 * MiB;
constexpr size_t WS_END = WS_Z + 224 * MiB;
static_assert((size_t)INW * DM * 2 == 28 * MiB && (size_t)DM * DM * 2 == 8 * MiB && (size_t)2 * DFF * DM * 2 == 44 * MiB && (size_t)DM * DFF * 2 == 22 * MiB, "weight map");
static_assert((size_t)M * DM * 2 == 64 * MiB && (size_t)M * INW * 2 == 224 * MiB && (size_t)M * DFF * 2 <= 224 * MiB, "activation map");
constexpr int LDS_BYTES = 147456;

#define LAS __attribute__((address_space(3)))
typedef unsigned short bf16_t;
typedef unsigned u32x4 __attribute__((ext_vector_type(4)));
typedef unsigned u32x2 __attribute__((ext_vector_type(2)));
typedef float f32x4 __attribute__((ext_vector_type(4)));
typedef short bf16x8 __attribute__((ext_vector_type(8)));
#define LDS_WAIT() asm volatile("s_waitcnt lgkmcnt(0)" ::: "memory")

__device__ __forceinline__ unsigned f2bf(float f) { unsigned u = __builtin_bit_cast(unsigned, f); return (u + 0x7fffu + ((u >> 16) & 1u)) >> 16; }
__device__ __forceinline__ unsigned pk2(float lo, float hi) { return pg8::cvt_pk_bf16(lo, hi); }
__device__ __forceinline__ float bf_lo(unsigned w) { return __builtin_bit_cast(float, w << 16); }
__device__ __forceinline__ float bf_hi(unsigned w) { return __builtin_bit_cast(float, w & 0xffff0000u); }
__device__ __forceinline__ float wave_sum(float v) {
#pragma unroll
    for (int o = 1; o < 64; o <<= 1) v += __shfl_xor(v, o);
    return v;
}

struct Args { const float* in[16]; float* out; unsigned char* ws; int ph_lo, ph_hi; };

__device__ __forceinline__ void transpose_item(const float* W, int K, int N, bf16_t* WT, int mode, const float* kscale, LAS float* scr, int item, int lane) {
    const int nblk = N / 32, kb = item / nblk, nb = item % nblk, k0 = 64 * kb, n0 = 32 * nb;
    const int drow = (mode == 0 || mode == 3) ? n0 : ((n0 >> 7) * 256 + (n0 & 127) + (mode == 2 ? 128 : 0));
    f32x4 t[8];
#pragma unroll
    for (int i = 0; i < 8; ++i) t[i] = *(const f32x4*)(W + (size_t)(k0 + 8 * i + (lane >> 3)) * N + n0 + 4 * (lane & 7));
#pragma unroll
    for (int i = 0; i < 8; ++i) { const int kk = 8 * i + (lane >> 3); const float sc = kscale ? kscale[k0 + kk] : 1.f; LAS float* d = scr + kk * 33 + 4 * (lane & 7);
        d[0] = t[i][0] * sc; d[1] = t[i][1] * sc; d[2] = t[i][2] * sc; d[3] = t[i][3] * sc; }
    LDS_WAIT(); asm volatile("" ::: "memory");
    const int c = lane & 7;
#pragma unroll
    for (int j = 0; j < 4; ++j) { const int n = (lane >> 3) + 8 * j; const LAS float* s = scr + (8 * c) * 33 + n;
        int dn = n;
        if (mode == 3 && n0 >= 2048 && n0 < 6144) { const int d = (n0 & 127) + n; dn = ((d >> 4) & 3) * 32 + ((d >> 2) & 3) * 8 + (d >> 6) * 4 + (d & 3) - (n0 & 127); }
        u32x4 o; o.x = pk2(s[0 * 33], s[1 * 33]); o.y = pk2(s[2 * 33], s[3 * 33]); o.z = pk2(s[4 * 33], s[5 * 33]); o.w = pk2(s[6 * 33], s[7 * 33]);
        *(u32x4*)(WT + (size_t)(drow + dn) * K + k0 + 8 * c) = o; }
    LDS_WAIT(); asm volatile("" ::: "memory");
}
__device__ __forceinline__ void convert_rows(const float* X, bf16_t* out, float* rsq, int gw, int ngw, int lane) {
    for (int m = gw; m < M; m += ngw) {
        const f32x4* xr = (const f32x4*)(X + (size_t)m * DM) + lane;
        f32x4 v[8]; float s = 0.f;
#pragma unroll
        for (int j = 0; j < 8; ++j) { v[j] = xr[64 * j]; s += (v[j].x * v[j].x + v[j].y * v[j].y) + (v[j].z * v[j].z + v[j].w * v[j].w); }
        s = wave_sum(s); if (lane == 0) rsq[m] = s;
        u32x2* o8 = (u32x2*)(out + (size_t)m * DM) + lane;
#pragma unroll
        for (int j = 0; j < 8; ++j) { u32x2 w; w.x = pk2(v[j].x, v[j].y); w.y = pk2(v[j].z, v[j].w); o8[64 * j] = w; }
    }
}
__device__ __forceinline__ void qk_prep(bf16_t* Z, const float* qn, const float* kn, const float* rope, int gw, int ngw, int lane) {
    const int i4 = 4 * (lane & 15);
    const f32x4 gq1 = *(const f32x4*)(qn + i4), gq2 = *(const f32x4*)(qn + 64 + i4), gk1 = *(const f32x4*)(kn + i4), gk2 = *(const f32x4*)(kn + 64 + i4);
    for (int it = gw; it < M * 8; it += 4 * ngw) {
        bf16_t* p[4]; u32x2 a[4], b[4]; f32x4 cs[4], sn[4]; bool ok[4], isq[4];
#pragma unroll
        for (int j = 0; j < 4; ++j) { const int itj = it + j * ngw; ok[j] = itj < M * 8; const int row = ok[j] ? itj >> 3 : 0, head = (itj & 7) * 4 + (lane >> 4); isq[j] = head < 24;
            p[j] = Z + (size_t)row * INW + C_Q + head * 128 + i4; const int pos = row & (SEQ - 1);
            a[j] = *(const u32x2*)p[j]; b[j] = *(const u32x2*)(p[j] + 64);
            cs[j] = *(const f32x4*)(rope + (size_t)pos * 64 + i4); sn[j] = *(const f32x4*)(rope + (size_t)SEQ * 64 + (size_t)pos * 64 + i4); }
#pragma unroll
        for (int j = 0; j < 4; ++j) {
            const float x1[4] = {bf_lo(a[j].x), bf_hi(a[j].x), bf_lo(a[j].y), bf_hi(a[j].y)}, x2[4] = {bf_lo(b[j].x), bf_hi(b[j].x), bf_lo(b[j].y), bf_hi(b[j].y)};
            float ss = (x1[0] * x1[0] + x1[1] * x1[1]) + (x1[2] * x1[2] + x1[3] * x1[3]) + (x2[0] * x2[0] + x2[1] * x2[1]) + (x2[2] * x2[2] + x2[3] * x2[3]);
            ss += __shfl_xor(ss, 1); ss += __shfl_xor(ss, 2); ss += __shfl_xor(ss, 4); ss += __shfl_xor(ss, 8);
            const float rstd = __builtin_amdgcn_rsqf(ss * (1.f / 128.f) + EPS);
            const f32x4 g1 = isq[j] ? gq1 : gk1, g2 = isq[j] ? gq2 : gk2;
            float o1[4], o2[4];
#pragma unroll
            for (int e = 0; e < 4; ++e) { const float y1 = x1[e] * rstd * g1[e], y2 = x2[e] * rstd * g2[e]; o1[e] = y1 * cs[j][e] - y2 * sn[j][e]; o2[e] = y2 * cs[j][e] + y1 * sn[j][e]; }
            u32x2 wa, wb; wa.x = pk2(o1[0], o1[1]); wa.y = pk2(o1[2], o1[3]); wb.x = pk2(o2[0], o2[1]); wb.y = pk2(o2[2], o2[3]);
            if (ok[j]) { *(u32x2*)p[j] = wa; *(u32x2*)(p[j] + 64) = wb; }
        }
    }
}
__device__ __forceinline__ void gmlp_unit(LAS unsigned char* lds, bf16_t* Z, const float* ln_g, const float* ln_b, const float* w_s, const float* b_s, int cidx, int g, int tid) {
    constexpr int LSTR = 272;
    LAS unsigned char* VT = lds; LAS unsigned char* WS = lds + 128 * LSTR;
    const int row0 = cidx * 128;
    u32x2 uu[8];
    { const int wv_ = tid >> 6, ln_ = tid & 63; const bf16_t* up_ = Z + (size_t)(row0 + wv_ * 16 + (ln_ & 15)) * INW + g * 128 + 4 * (ln_ >> 4);
#pragma unroll
      for (int ct = 0; ct < 8; ++ct) uu[ct] = *(const u32x2*)(up_ + 16 * ct); }
    {
        const int j = tid >> 2, cq = (tid & 3) * 32;
        const bf16_t* vp = Z + (size_t)(row0 + j) * INW + 1024 + g * 128 + cq;
        u32x4 raw[4];
#pragma unroll
        for (int q = 0; q < 4; ++q) raw[q] = *(const u32x4*)(vp + 8 * q);
        float x[32];
#pragma unroll
        for (int q = 0; q < 4; ++q)
#pragma unroll
            for (int e = 0; e < 4; ++e) { x[8 * q + 2 * e] = bf_lo(raw[q][e]); x[8 * q + 2 * e + 1] = bf_hi(raw[q][e]); }
        float s = 0.f;
#pragma unroll
        for (int c = 0; c < 32; ++c) s += x[c];
        s += __shfl_xor(s, 1); s += __shfl_xor(s, 2);
        const float mean = s * (1.f / 128.f); float q2 = 0.f;
#pragma unroll
        for (int c = 0; c < 32; ++c) { x[c] -= mean; q2 += x[c] * x[c]; }
        q2 += __shfl_xor(q2, 1); q2 += __shfl_xor(q2, 2);
        const float rstd = __builtin_amdgcn_rsqf(q2 * (1.f / 128.f) + EPS);
        const float* gp = ln_g + g * 128 + cq; const float* bp = ln_b + g * 128 + cq;
#pragma unroll
        for (int c4 = 0; c4 < 8; ++c4) { const f32x4 gg = *(const f32x4*)(gp + 4 * c4), bb = *(const f32x4*)(bp + 4 * c4);
#pragma unroll
            for (int e = 0; e < 4; ++e) { const int c = 4 * c4 + e; const float y = x[c] * rstd * gg[e] + bb[e];
                *(LAS unsigned short*)(VT + (cq + c) * LSTR + j * 2) = (unsigned short)f2bf(y); } }
    }
    {
        const int i = tid >> 2, jq = (tid & 3) * 32;
        const float* wp = w_s + ((size_t)g * 128 + i) * 128 + jq;
#pragma unroll
        for (int q = 0; q < 4; ++q) { f32x4 a = *(const f32x4*)(wp + 8 * q), b = *(const f32x4*)(wp + 8 * q + 4);
            const int j0 = jq + 8 * q;
#pragma unroll
            for (int e = 0; e < 4; ++e) { if (j0 + e > i) a[e] = 0.f; if (j0 + 4 + e > i) b[e] = 0.f; }
            u32x4 w; w.x = pk2(a[0], a[1]); w.y = pk2(a[2], a[3]); w.z = pk2(b[0], b[1]); w.w = pk2(b[2], b[3]);
            *(LAS u32x4*)(WS + i * LSTR + j0 * 2) = w; }
    }
    __syncthreads();
    const int wv = tid >> 6, lane = tid & 63, fr = lane & 15, fq = lane >> 4;
    f32x4 acc[8];
#pragma unroll
    for (int ct = 0; ct < 8; ++ct) acc[ct] = (f32x4){0.f, 0.f, 0.f, 0.f};
#pragma unroll
    for (int ks = 0; ks < 4; ++ks) {
        const bf16x8 bw = *(const LAS bf16x8*)(WS + (wv * 16 + fr) * LSTR + (ks * 32 + fq * 8) * 2);
#pragma unroll
        for (int ct = 0; ct < 8; ++ct) { const bf16x8 av = *(const LAS bf16x8*)(VT + (ct * 16 + fr) * LSTR + (ks * 32 + fq * 8) * 2);
            acc[ct] = __builtin_amdgcn_mfma_f32_16x16x32_bf16(av, bw, acc[ct], 0, 0, 0); }
    }
    {
        const int i = wv * 16 + fr; const float bs = b_s[g * 128 + i];
        bf16_t* up = Z + (size_t)(row0 + i) * INW + g * 128 + 4 * fq;
#pragma unroll
        for (int ct = 0; ct < 8; ++ct) {
            u32x2 w; w.x = pk2(bf_lo(uu[ct].x) * (acc[ct][0] + bs), bf_hi(uu[ct].x) * (acc[ct][1] + bs)); w.y = pk2(bf_lo(uu[ct].y) * (acc[ct][2] + bs), bf_hi(uu[ct].y) * (acc[ct][3] + bs));
            *(u32x2*)(up + 16 * ct) = w; }
    }
    __syncthreads();
}
__device__ __forceinline__ void merge_rows(bf16_t* Z, const float* LSE, const float* ga, const float* gb, int gw, int ngw, int lane) {
    const int ch0 = lane * 16, head = lane >> 3;
    for (int m = gw; m < M; m += ngw) {
        bf16_t* zr = Z + (size_t)m * INW;
        const float l0 = LSE[((size_t)0 * M + m) * 8 + head], l1 = LSE[((size_t)1 * M + m) * 8 + head], l2 = LSE[((size_t)2 * M + m) * 8 + head];
        const float mx = fmaxf(l0, fmaxf(l1, l2));
        float e0 = __builtin_amdgcn_exp2f((l0 - mx) * 1.4426950408889634f), e1 = __builtin_amdgcn_exp2f((l1 - mx) * 1.4426950408889634f), e2 = __builtin_amdgcn_exp2f((l2 - mx) * 1.4426950408889634f);
        const float inv = __builtin_amdgcn_rcpf(e0 + e1 + e2); e0 *= inv; e1 *= inv; e2 *= inv;
        float ob[16], oa[16];
#pragma unroll
        for (int h2 = 0; h2 < 2; ++h2) {
            const u32x4 q0 = *(const u32x4*)(zr + C_Q + ch0 + 8 * h2), q1 = *(const u32x4*)(zr + C_Q + 1024 + ch0 + 8 * h2), q2 = *(const u32x4*)(zr + C_Q + 2048 + ch0 + 8 * h2), aa = *(const u32x4*)(zr + ch0 + 8 * h2);
#pragma unroll
            for (int e = 0; e < 4; ++e) {
                ob[8 * h2 + 2 * e] = e0 * bf_lo(q0[e]) + e1 * bf_lo(q1[e]) + e2 * bf_lo(q2[e]); ob[8 * h2 + 2 * e + 1] = e0 * bf_hi(q0[e]) + e1 * bf_hi(q1[e]) + e2 * bf_hi(q2[e]);
                oa[8 * h2 + 2 * e] = bf_lo(aa[e]); oa[8 * h2 + 2 * e + 1] = bf_hi(aa[e]); }
        }
        float sb = 0.f, sa = 0.f;
#pragma unroll
        for (int c = 0; c < 16; ++c) { sb += ob[c] * ob[c]; sa += oa[c] * oa[c]; }
        sb = wave_sum(sb); sa = wave_sum(sa);
        const float rb = __builtin_amdgcn_rsqf(sb * (1.f / 1024.f) + EPS), ra = __builtin_amdgcn_rsqf(sa * (1.f / 1024.f) + EPS);
        bf16_t* mr = zr;
#pragma unroll
        for (int h2 = 0; h2 < 2; ++h2) {
            const f32x4 ga0 = *(const f32x4*)(ga + ch0 + 8 * h2), ga1 = *(const f32x4*)(ga + ch0 + 8 * h2 + 4), gb0 = *(const f32x4*)(gb + ch0 + 8 * h2), gb1 = *(const f32x4*)(gb + ch0 + 8 * h2 + 4);
            u32x4 wa, wb; const float* A = oa + 8 * h2; const float* B = ob + 8 * h2;
            wa.x = pk2(A[0] * ra * ga0[0], A[1] * ra * ga0[1]); wa.y = pk2(A[2] * ra * ga0[2], A[3] * ra * ga0[3]); wa.z = pk2(A[4] * ra * ga1[0], A[5] * ra * ga1[1]); wa.w = pk2(A[6] * ra * ga1[2], A[7] * ra * ga1[3]);
            wb.x = pk2(B[0] * rb * gb0[0], B[1] * rb * gb0[1]); wb.y = pk2(B[2] * rb * gb0[2], B[3] * rb * gb0[3]); wb.z = pk2(B[4] * rb * gb1[0], B[5] * rb * gb1[1]); wb.w = pk2(B[6] * rb * gb1[2], B[7] * rb * gb1[3]);
            *(u32x4*)(mr + ch0 + 8 * h2) = wa; *(u32x4*)(mr + 1024 + ch0 + 8 * h2) = wb;
        }
    }
}
typedef swa::BlockRef<__hip_bfloat16, __hip_bfloat16> ABlock;
__device__ __forceinline__ ABlock attn_ref(int id, bf16_t* Zb, float* LSE) {
    __hip_bfloat16* Z = (__hip_bfloat16*)Zb;
    const int bh = id / 48, w48 = id - bh * 48, g = w48 >> 4, w16 = w48 & 15, b = bh >> 3, h = bh & 7;
    const int r = 1 << (2 * g), nqb = 16 >> (2 * g), rho = w16 / nqb, qb = w16 - rho * nqb;
    const size_t tok0 = (size_t)b * SEQ + rho, tokq = tok0 + (size_t)r * 256 * qb;
    ABlock R;
    R.K = Z + tok0 * INW + C_K + h * 128; R.V = Z + tok0 * INW + C_V + h * 128;
    R.Q = Z + tokq * INW + C_Q + g * 1024 + h * 128; R.O = Z + tokq * INW + C_Q + g * 1024 + h * 128;
    R.L = LSE + ((size_t)g * M + tokq) * 8 + h; R.P0 = 256 * qb; R.pitch = r * INW; R.lpitch = r * 8;
    return R;
}

#define RLX_AGENT __ATOMIC_RELAXED, __HIP_MEMORY_SCOPE_AGENT
#define XB_TMO      128
#define XB_XCNT(j)  (256  + 64 * (j))
#define XB_XSUB(j)  (1280 + 64 * (j))
#define XB_XGEN(j)  (2304 + 64 * (j))
#define XB_TOP      3328
#define XB_TOPGEN   3392
#define XCD_BAR_WORDS 3456
#define XB_SPIN_CAP (1u << 18)

__device__ __forceinline__ unsigned xb_ld(unsigned* p)              { return __hip_atomic_load(p, __ATOMIC_RELAXED, __HIP_MEMORY_SCOPE_AGENT); }
__device__ __forceinline__ unsigned xb_add(unsigned* p, unsigned v) { return __hip_atomic_fetch_add(p, v, __ATOMIC_RELAXED, __HIP_MEMORY_SCOPE_AGENT); }
__device__ __forceinline__ unsigned xb_xcc_id() { return (unsigned)__builtin_amdgcn_s_getreg((3 << 11) | 20) & 0xFu; }
#define XB_SPIN(cond, bar) do { unsigned _sp = 0; while (cond) { __builtin_amdgcn_s_sleep(1); \
    if ((++_sp & 255u) == 0u) { if (xb_ld(&(bar)[XB_TMO])) break; if (_sp > XB_SPIN_CAP) { atomicAdd(&(bar)[XB_TMO], 1u); break; } } } } while (0)

struct XcdBarrier {
    unsigned* bar; unsigned x;
    volatile LAS unsigned* st;
};

__device__ __forceinline__ XcdBarrier xcd_barrier_post(unsigned* bar, volatile LAS unsigned* st) {
    XcdBarrier b; b.bar = bar; b.x = xb_xcc_id(); b.st = st;
    if (threadIdx.x == 0) (void)xb_add(&bar[XB_XCNT(b.x)], 1u);
    return b;
}
__device__ __forceinline__ void xcd_barrier_complete(unsigned* bar, unsigned x, unsigned& nloc, unsigned& nx) {
    const unsigned G = gridDim.x * gridDim.y * gridDim.z;
    unsigned sum, cnt, mine, sp = 0u;
    for (;;) {
        sum = 0u; cnt = 0u; mine = 0u;
#pragma unroll
        for (unsigned j = 0; j < 16; ++j) { const unsigned c = xb_ld(&bar[XB_XCNT(j)]); sum += c; cnt += (c > 0u) ? 1u : 0u; mine = (j == x) ? c : mine; }
        if (sum == G) break;
        __builtin_amdgcn_s_sleep(1);
        if ((++sp & 255u) == 0u) { if (xb_ld(&bar[XB_TMO])) break; if (sp > XB_SPIN_CAP) { atomicAdd(&bar[XB_TMO], 1u); break; } }
    }
    nloc = mine > 0u ? mine : 1u; nx = cnt > 0u ? cnt : 1u;
}

__device__ __forceinline__ void xcd_barrier(const XcdBarrier& b) {
    asm volatile("s_waitcnt vmcnt(0)" ::: "memory");
    __syncthreads();
    if (threadIdx.x == 0) {
        unsigned* bar = b.bar;
        __builtin_amdgcn_s_waitcnt(0);
        unsigned nloc = b.st[0], nx = b.st[1];
        if (nloc == 0u) { xcd_barrier_complete(bar, b.x, nloc, nx); b.st[0] = nloc; b.st[1] = nx; }
        const unsigned old = xb_add(&bar[XB_XSUB(b.x)], 1u);
        const unsigned gen = old / nloc;
        if (old + 1u == (gen + 1u) * nloc) {
            __builtin_amdgcn_fence(__ATOMIC_RELEASE, "agent");
            asm volatile("s_waitcnt vmcnt(0)" ::: "memory");
            const unsigned og = xb_add(&bar[XB_TOP], 1u);
            const unsigned tg = og / nx;
            if (og + 1u == (tg + 1u) * nx) xb_add(&bar[XB_TOPGEN], 1u);
            else XB_SPIN(xb_ld(&bar[XB_TOPGEN]) == tg, bar);
            __builtin_amdgcn_fence(__ATOMIC_ACQUIRE, "agent");
            xb_add(&bar[XB_XGEN(b.x)], 1u);
            asm volatile("s_waitcnt vmcnt(0)" ::: "memory");
        } else {
            XB_SPIN(xb_ld(&bar[XB_XGEN(b.x)]) == gen, bar);
            __builtin_amdgcn_fence(__ATOMIC_ACQUIRE, "agent");
            asm volatile("s_waitcnt vmcnt(0)" ::: "memory");
        }
    }
    __syncthreads();
}

constexpr int PH_PER_LAYER = 7, N_PHASES = 1 + DEPTH * PH_PER_LAYER;
typedef const __attribute__((address_space(4))) Args* KArgs;
#define KARGS(A) KArgs A = (KArgs)__builtin_amdgcn_kernarg_segment_ptr(); asm volatile("" : "+s"(A))
#define PH_COMMON() KARGS(A); const int tid = ltid(), lane = tid & 63, wave = __builtin_amdgcn_readfirstlane(tid >> 6); const int G = gridDim.x, gw = blockIdx.x * NWAVES + wave, ngw = G * NWAVES; \
    unsigned char* ws = A->ws; (void)lane; (void)gw; (void)ngw; (void)ws
__global__ void __launch_bounds__(NWAVES * 64, 2) fwd_kernel(Args args_) {
    extern __shared__ __attribute__((aligned(16))) unsigned char lds[];
    int ph, ph_hi; { KARGS(A0); ph = A0->ph_lo; ph_hi = A0->ph_hi; }
#if ONE_LAUNCH
    { LAS unsigned* misc = (LAS unsigned*)((LAS unsigned char*)lds + MISC_OFF); if (threadIdx.x < 32) misc[threadIdx.x] = 0u; __syncthreads();
      KARGS(A0); (void)xcd_barrier_post((unsigned*)(A0->ws + WS_CTL) + CW_BAR, (volatile LAS unsigned*)(misc + 8)); }
#endif
#pragma unroll 1
    for (; ph < ph_hi; ++ph) {
#if NPASS > 1
        const int pe = ph >= N_PHASES ? ph - N_PHASES : ph;
        if (ph == N_PHASES) { KARGS(Az); float* rz = (float*)(Az->ws + WS_RSQ) + M; for (int i = blockIdx.x * 512 + threadIdx.x; i < 3 * M; i += gridDim.x * 512) rz[i] = 0.f; }
#else
        const int pe = ph;
#endif
        const int l = pe == 0 ? 0 : (pe - 1) / PH_PER_LAYER, s = pe == 0 ? -1 : (pe - 1) % PH_PER_LAYER;
        switch ((NPASS > 1 && ph < N_PHASES && ((PROBE_SKIP >> (s + 1)) & 1)) ? 99 : s) {
        case -1: for (int rep_ = 0; rep_ <= PROBE_DUP_PROLOGUE; ++rep_) {
            PH_COMMON(); LAS unsigned char* lds3 = (LAS unsigned char*)lds;
            LAS float* scr = (LAS float*)(lds3 + wave * 16384);
            constexpr int I_IN = (DM / 64) * (INW / 32), I_OUT = (DM / 64) * (DM / 32), I_G = (DM / 64) * (DFF / 32), I_D = (DFF / 64) * (DM / 32), I_L = I_IN + I_OUT + 2 * I_G + I_D;
            for (int it = gw; it < DEPTH * I_L; it += ngw) {
                const int li = it / I_L; int r = it - li * I_L; unsigned char* wd = ws + WS_W + (size_t)li * W_LAYER;
                if (r < I_IN) { transpose_item(A->in[2] + (size_t)li * DM * INW, DM, INW, (bf16_t*)(wd + W_IN_OFF), 3, A->in[1] + (size_t)li * DM, scr, r, lane); continue; } r -= I_IN;
                if (r < I_OUT) { transpose_item(A->in[11] + (size_t)li * DM * DM, DM, DM, (bf16_t*)(wd + W_OUT_OFF), 0, nullptr, scr, r, lane); continue; } r -= I_OUT;
                if (r < I_G) { transpose_item(A->in[13] + (size_t)li * DM * DFF, DM, DFF, (bf16_t*)(wd + W_GU_OFF), 1, A->in[12] + (size_t)li * DM, scr, r, lane); continue; } r -= I_G;
                if (r < I_G) { transpose_item(A->in[14] + (size_t)li * DM * DFF, DM, DFF, (bf16_t*)(wd + W_GU_OFF), 2, A->in[12] + (size_t)li * DM, scr, r, lane); continue; } r -= I_G;
                transpose_item(A->in[15] + (size_t)li * DFF * DM, DFF, DM, (bf16_t*)(wd + W_DN_OFF), 0, nullptr, scr, r, lane);
            }
            float* rope = (float*)(ws + WS_ROPE);
            for (int e = blockIdx.x * (NWAVES * 64) + tid; e < SEQ * 64; e += G * NWAVES * 64) {
                const int pos = e >> 6, i = e & 63;
                const float inv_freq = __builtin_amdgcn_exp2f(-(float)(2 * i) * (1.0f / 128.0f) * 13.287712379549449f);
                const float ang = (float)pos * inv_freq;
                double rev = (double)ang * 0.15915494309189535; rev -= __builtin_rint(rev);
                ((unsigned*)rope)[e] = pk2(__builtin_amdgcn_cosf((float)rev), __builtin_amdgcn_sinf((float)rev));
            }
            convert_rows(A->in[0], (bf16_t*)(ws + WS_XN), (float*)(ws + WS_RSQ), gw, ngw, lane);
        } break;
#ifndef NO_G1
        case 0: {
            PH_COMMON();
            pg8::Gemm g{(const bf16_t*)(ws + WS_XN), (const bf16_t*)(ws + WS_W + (size_t)l * W_LAYER + W_IN_OFF), M, INW, DM, DM}; pg8::StaticOrder S; S.init(M, INW, G, (int)blockIdx.x);
            pg8::RowScale rsc{(const float*)(ws + WS_RSQ) + (size_t)(l == 0 ? 0 : 2) * 8 * M, l == 0 ? 1 : 8, M, (LAS float*)((LAS unsigned char*)lds + RT_OFF)};
            pg8::EpiZ E{(bf16_t*)(ws + WS_Z), INW, rsc, A->in[7] + (size_t)l * 128, A->in[8] + (size_t)l * 128, (const float*)(ws + WS_ROPE), (LAS float*)((LAS unsigned char*)lds + XL_OFF)};
            pg8::gemm_phase<pg8::EpiZ, pg8::StaticOrder, true, true>((LAS unsigned char*)lds, g, S, E);
        } break;
#endif
#ifndef NO_MIX
        case 1: {
            PH_COMMON(); bf16_t* Z = (bf16_t*)(ws + WS_Z);
            const float* lng = A->in[3] + (size_t)l * 1024; const float* lnb = A->in[4] + (size_t)l * 1024;
            const float* wsp = A->in[5] + (size_t)l * 8 * 128 * 128; const float* bsp = A->in[6] + (size_t)l * 1024;
            for (int u = blockIdx.x; u < (M / 128) * 8; u += G) gmlp_unit((LAS unsigned char*)lds, Z, lng, lnb, wsp, bsp, u >> 3, u & 7, tid);
        } break;
#endif
#ifndef NO_ATTN
        case 2: {
            KARGS(A); bf16_t* Z = (bf16_t*)(A->ws + WS_Z); float* LSE = (float*)(A->ws + WS_LSE); const int G = gridDim.x;
            constexpr int TOTAL = NBATCH * 8 * 48;
            const bool xl8 = (G == 256); const int vcu = (blockIdx.x & 7) * 32 + (blockIdx.x >> 3);
#define ATT_ID(i) (xl8 ? ((vcu >> 3) * 48 + ((i) >> 1) * 16 + 2 * (vcu & 7) + ((i) & 1)) : ((int)blockIdx.x + (i) * G))
#define ATT_MORE(i) (xl8 ? (i) < 6 : ((int)blockIdx.x + (i) * G) < TOTAL)
            int i = 0;
            if (ATT_MORE(0)) {
                ABlock cur = attn_ref(ATT_ID(0), Z, LSE);
                swa::Seam<__hip_bfloat16> S;
                swa::causal_swa_prime<__hip_bfloat16, __hip_bfloat16>(cur, 129, (char*)lds, S);
                for (;;) {
                    const bool last = !ATT_MORE(i + 1);
                    const ABlock nxt = last ? cur : attn_ref(ATT_ID(i + 1), Z, LSE);
                    swa::causal_swa_block<__hip_bfloat16, __hip_bfloat16>(cur, nxt, SEQ, 129, (char*)lds, S);
                    if (last) break;
                    cur = nxt; ++i;
                }
            }
#undef ATT_ID
#undef ATT_MORE
        } break;
#endif
#ifndef NO_MERGE
        case 3: { PH_COMMON(); merge_rows((bf16_t*)(ws + WS_Z), (const float*)(ws + WS_LSE), A->in[9] + (size_t)l * 1024, A->in[10] + (size_t)l * 1024, gw, ngw, lane); } break;
#endif
#ifndef NO_G5
        case 4: {
            PH_COMMON();
            pg8::Gemm g{(const bf16_t*)(ws + WS_Z), (const bf16_t*)(ws + WS_W + (size_t)l * W_LAYER + W_OUT_OFF), M, DM, DM, INW}; pg8::StaticOrder S; S.init(M, DM, G, (int)blockIdx.x);
            pg8::EpiRes E{(bf16_t*)(ws + WS_XN), nullptr, DM, (float*)(ws + WS_RSQ) + (size_t)(l == 0 ? 1 : 3) * 8 * M, M, (LAS float*)((LAS unsigned char*)lds + XL_OFF)};
            pg8::gemm_phase<pg8::EpiRes, pg8::StaticOrder, true, true>((LAS unsigned char*)lds, g, S, E);
        } break;
#endif
#ifndef NO_G7
        case 5: {
            PH_COMMON();
            pg8::Gemm g{(const bf16_t*)(ws + WS_XN), (const bf16_t*)(ws + WS_W + (size_t)l * W_LAYER + W_GU_OFF), M, 2 * DFF, DM, DM}; pg8::StaticOrder S; S.init(M, 2 * DFF, G, (int)blockIdx.x);
            pg8::RowScale rsc{(const float*)(ws + WS_RSQ) + (size_t)(l == 0 ? 1 : 3) * 8 * M, 8, M, (LAS float*)((LAS unsigned char*)lds + RT_OFF)};
            pg8::EpiSwiGLU E{(bf16_t*)(ws + WS_Z), DFF, rsc};
            pg8::gemm_phase<pg8::EpiSwiGLU, pg8::StaticOrder, true, true>((LAS unsigned char*)lds, g, S, E);
        } break;
#endif
#ifndef NO_G8
        case 6: {
            PH_COMMON();
            pg8::Gemm g{(const bf16_t*)(ws + WS_Z), (const bf16_t*)(ws + WS_W + (size_t)l * W_LAYER + W_DN_OFF), M, DM, DFF, DFF}; pg8::StaticOrder S; S.init(M, DM, G, (int)blockIdx.x);
            pg8::EpiRes E{(bf16_t*)(ws + WS_XN), l == 0 ? (float*)nullptr : A->out, DM, l == 0 ? (float*)(ws + WS_RSQ) + (size_t)2 * 8 * M : (float*)nullptr, M, (LAS float*)((LAS unsigned char*)lds + XL_OFF)};
            pg8::gemm_phase<pg8::EpiRes, pg8::StaticOrder, true, true>((LAS unsigned char*)lds, g, S, E);
        } break;
#endif
        default: break;
        }
#if ONE_LAUNCH
        if (ph + 1 < ph_hi && s != 1) {
            if (ph_hi < 0) cg::this_grid().sync();
            { KARGS(Ab); XcdBarrier b; b.bar = (unsigned*)(Ab->ws + WS_CTL) + CW_BAR; b.x = xb_xcc_id(); b.st = (volatile LAS unsigned*)((LAS unsigned char*)lds + MISC_OFF) + 8; xcd_barrier(b); }
        }
#endif
    }
}

extern "C" void kernel_launch(void* const* d_in, const int* in_sizes, int n_in, void* d_out, int out_size, void* d_ws, size_t ws_size, hipStream_t stream) {
    static int grid = 0;
    if (grid == 0) {
        if (n_in != 16 || out_size != M * DM || ws_size < WS_END) { fprintf(stderr, "kernel_launch: unexpected shapes (n_in %d out %d ws %zu)\n", n_in, out_size, ws_size); grid = -1; return; }
        int dev = 0, cus = 0, per_cu = 0;
        (void)hipGetDevice(&dev); (void)hipDeviceGetAttribute(&cus, hipDeviceAttributeMultiprocessorCount, dev);
        if (hipFuncSetAttribute((const void*)fwd_kernel, hipFuncAttributeMaxDynamicSharedMemorySize, LDS_BYTES) != hipSuccess) fprintf(stderr, "kernel_launch: hipFuncSetAttribute failed\n");
        if (hipOccupancyMaxActiveBlocksPerMultiprocessor(&per_cu, (const void*)fwd_kernel, NWAVES * 64, LDS_BYTES) != hipSuccess || per_cu < 1) per_cu = 1;
        (void)hipGetLastError();
        if (cus <= 0) cus = 256;
        if (cus * per_cu < 256) { fprintf(stderr, "kernel_launch: needs 256 co-resident workgroups (have %d x %d)\n", cus, per_cu); grid = -1; return; }
        grid = 256;
    }
    if (grid < 0) return;
    (void)hipMemsetAsync((char*)d_ws + WS_CTL, 0, CTL_ZERO_BYTES, stream);
    Args a{};
    for (int i = 0; i < 16; ++i) a.in[i] = (const float*)d_in[i];
    a.out = (float*)d_out; a.ws = (unsigned char*)d_ws;
#if ONE_LAUNCH
    a.ph_lo = 0; a.ph_hi = NPASS * N_PHASES;
    void* kargs[] = {&a};
    hipError_t e = hipLaunchCooperativeKernel((const void*)fwd_kernel, dim3(grid), dim3(NWAVES * 64), kargs, LDS_BYTES, stream);
    if (e != hipSuccess) fprintf(stderr, "kernel_launch: cooperative launch failed: %s (grid %d)\n", hipGetErrorString(e), grid);
#else
    for (int ph = 0; ph < N_PHASES; ++ph) { a.ph_lo = ph; a.ph_hi = ph + 1; hipLaunchKernelGGL(fwd_kernel, dim3(grid), dim3(NWAVES * 64), LDS_BYTES, stream, a); }
#endif
}
```

```cpp
#include <hip/hip_runtime.h>
#include <hip/hip_bf16.h>
#include <hip/hip_cooperative_groups.h>
#include <cstdio>
#include <cstdint>
namespace cg = cooperative_groups;
__device__ __forceinline__ int ltid() { int t = threadIdx.x; asm volatile("" : "+v"(t)); return t; }
namespace pg8 {
#define PG8_LAS __attribute__((address_space(3)))
typedef unsigned short bf16_t;
typedef short bf16x8 __attribute__((ext_vector_type(8)));
typedef float f32x4 __attribute__((ext_vector_type(4)));
typedef unsigned u32x4 __attribute__((ext_vector_type(4)));
constexpr int BM = 256, BK = 64, HALF = 128, HTB = HALF * BK * 2  , STAGE_BYTES = 8 * HTB, NXCD = 8, WGM = 8;

__host__ __device__ __forceinline__ int lds_byte(int r, int c) { const int st = (r >> 4) * 2 + (c >> 5), rr = r & 15, cc = c & 31, ob = rr * 64 + cc * 2; return st * 1024 + (ob ^ (((ob >> 9) & 1) << 5)); }
__host__ __device__ __forceinline__ void stage_rc(int b, int& R, int& C) { const int st = b / 1024, sb = b % 1024, swz = sb ^ (((sb >> 9) & 1) << 5); R = (st >> 1) * 16 + swz / 64; C = (st & 1) * 32 + (swz % 64) / 2; }
__host__ __device__ __forceinline__ int perm32(int rho) { const int n = rho >> 4, i = rho & 15; return 8 * (i >> 2) + 4 * n + (i & 3); }

struct Unit { int pm, pn; };
struct Gemm { const bf16_t* A; const bf16_t* Bt; int M, N, K, lda; };

struct StaticOrder {
    int nM, nN, nwg, G, c;
    __host__ __device__ void init(int M, int N, int G_, int c_) { nM = M / BM; nN = N / BM; nwg = nM * nN; G = G_; c = c_; }
    __host__ __device__ bool next(int i, Unit& u) const {
        const long L = (long)i * G + c; if (L >= nwg) return false;
        int wgid = (int)L; { const int q = nwg / NXCD, r = nwg % NXCD, xcd = wgid % NXCD, off = wgid / NXCD; wgid = (xcd < r ? xcd * (q + 1) : r * (q + 1) + (xcd - r) * q) + off; }
        const int nig = WGM * nN, gid = wgid / nig, fm = gid * WGM, gsz = (nM - fm) < WGM ? (nM - fm) : WGM;
        u.pm = fm + ((wgid % nig) % gsz); u.pn = (wgid % nig) / gsz; return true;
    }
    __device__ __forceinline__ void a_ready(const Unit&) const {}
    __device__ __forceinline__ void done(const Unit&) const {}
};

__device__ __forceinline__ unsigned cvt_pk_bf16(float lo, float hi) { unsigned r; asm volatile("v_cvt_pk_bf16_f32 %0, %1, %2" : "=v"(r) : "v"(lo), "v"(hi)); return r; }
typedef float f32x2 __attribute__((ext_vector_type(2)));
__device__ __forceinline__ f32x2 gelu_pk(f32x2 v) {
    const f32x2 av = __builtin_elementwise_abs(v), d = av * 0.2316418882f + 1.0f;
    f32x2 t; t.x = __builtin_amdgcn_rcpf(d.x); t.y = __builtin_amdgcn_rcpf(d.y);
    f32x2 q = t * 0.5307027145f + (-0.7265760135f); q = q * t + 0.7107068705f; q = q * t + (-0.142248368f); q = q * t + 0.127414796f; q = q * t;
    const f32x2 s = (v * v) * (-0.72134752044f);
    f32x2 e; e.x = __builtin_amdgcn_exp2f(s.x); e.y = __builtin_amdgcn_exp2f(s.y);
    const f32x2 m = v * (q * e), r = v - m;
    f32x2 o; o.x = v.x < 0.f ? m.x : r.x; o.y = v.y < 0.f ? m.y : r.y; return o;
}
typedef unsigned u32x2 __attribute__((ext_vector_type(2)));
struct RowScale {
    const float* rsq; int nparts; int mtot; PG8_LAS float* tab;
    __device__ __forceinline__ int begin(const Unit& u) const {
        const int t = ltid();
        if (t < BM) { float v[8];
#pragma unroll
            for (int p = 0; p < 8; ++p) v[p] = rsq[(size_t)(p < nparts ? p : 0) * mtot + u.pm * BM + t];
            float s = v[0];
#pragma unroll
            for (int p = 1; p < 8; ++p) s += (p < nparts) ? v[p] : 0.f;
            tab[t] = s; }
        asm volatile("s_waitcnt lgkmcnt(0)\n\ts_barrier" ::: "memory");
        return u.pm;
    }
    __device__ __forceinline__ void preload(const Unit&, int, int wr, int fr, float (&pre)[8]) const {
#pragma unroll
        for (int i = 0; i < 8; ++i) pre[i] = tab[wr * 64 + fr + (i >> 2) * HALF + (i & 3) * 16];
    }
};
__device__ __forceinline__ float silu_f(float x) { return x * __builtin_amdgcn_rcpf(1.0f + __builtin_amdgcn_exp2f(-1.4426950408889634f * x)); }
struct EpiZ {
    static constexpr bool PERM = true, AFTER_DRAIN = false;
    bf16_t* O; int ldc; RowScale rsc; const float* qg; const float* kg; const float* rope; PG8_LAS float* xl;
    __device__ __forceinline__ int begin(const Unit& u) const { return rsc.begin(u); }
    __device__ __forceinline__ void preload(const Unit& u, int tab_pm, int wr, int fr, float (&pre)[8]) const { rsc.preload(u, tab_pm, wr, fr, pre); }
    __device__ __forceinline__ void operator()(const f32x4 (&acc)[2][2][4][2], const Unit& u, int wr, int wc, int fr, int fq, const float (&pre)[8]) const {
        const int row0 = u.pm * BM + wr * 64 + fr; const int col0 = u.pn * BM + wc * 32 + 8 * fq;
        if (u.pn >= 8 && u.pn < 24) {
            float rsv[2][4];
            u32x4 csv[2][4];
#pragma unroll
            for (int ai = 0; ai < 2; ++ai)
#pragma unroll
                for (int m = 0; m < 4; ++m) csv[ai][m] = *(const u32x4*)((const unsigned*)rope + (size_t)((row0 + ai * HALF + m * 16) & 4095) * 64 + 16 * wc + 4 * fq);
            asm volatile("" ::: "memory");
#pragma unroll
            for (int ai = 0; ai < 2; ++ai)
#pragma unroll
                for (int m = 0; m < 4; ++m) { const float rs = __builtin_amdgcn_rsqf(pre[ai * 4 + m] * (1.f / 2048.f) + 1e-6f); rsv[ai][m] = rs;
#pragma unroll
                    for (int bj = 0; bj < 2; ++bj) { const f32x4 a = acc[ai][bj][m][0] * rs, b = acc[ai][bj][m][1] * rs;
                        float ss = ((a[0] * a[0] + a[1] * a[1]) + (a[2] * a[2] + a[3] * a[3])) + ((b[0] * b[0] + b[1] * b[1]) + (b[2] * b[2] + b[3] * b[3]));
                        ss += __shfl_xor(ss, 16); ss += __shfl_xor(ss, 32);
                        if (fq == 0) xl[((ai * HALF + wr * 64 + m * 16 + fr) * 2 + bj) * 4 + wc] = ss; } }
            const float* gn = (u.pn < 20 ? qg : kg) + 16 * wc + 4 * fq;
            const f32x4 g1 = *(const f32x4*)gn, g2 = *(const f32x4*)(gn + 64);
            asm volatile("s_waitcnt lgkmcnt(0)\n\ts_barrier" ::: "memory");
#pragma unroll
            for (int ai = 0; ai < 2; ++ai)
#pragma unroll
                for (int m = 0; m < 4; ++m) { const int row = row0 + ai * HALF + m * 16; bf16_t* rowp = O + (size_t)row * ldc + col0; const float rs = rsv[ai][m];
                    const u32x4 cw = csv[ai][m]; const f32x4 cs = {__builtin_bit_cast(float, cw.x << 16), __builtin_bit_cast(float, cw.y << 16), __builtin_bit_cast(float, cw.z << 16), __builtin_bit_cast(float, cw.w << 16)},
                        sn = {__builtin_bit_cast(float, cw.x & 0xffff0000u), __builtin_bit_cast(float, cw.y & 0xffff0000u), __builtin_bit_cast(float, cw.z & 0xffff0000u), __builtin_bit_cast(float, cw.w & 0xffff0000u)};
#pragma unroll
                    for (int bj = 0; bj < 2; ++bj) { const f32x4 p = *(const PG8_LAS f32x4*)(xl + ((ai * HALF + wr * 64 + m * 16 + fr) * 2 + bj) * 4);
                        const float rh = rs * __builtin_amdgcn_rsqf(((p[0] + p[1]) + (p[2] + p[3])) * (1.f / 128.f) + 1e-6f);
                        const f32x4 y1 = acc[ai][bj][m][0] * rh * g1, y2 = acc[ai][bj][m][1] * rh * g2;
                        const f32x4 o1 = y1 * cs - y2 * sn, o2 = y2 * cs + y1 * sn;
                        u32x4 w; w.x = cvt_pk_bf16(o1[0], o1[1]); w.y = cvt_pk_bf16(o1[2], o1[3]); w.z = cvt_pk_bf16(o2[0], o2[1]); w.w = cvt_pk_bf16(o2[2], o2[3]);
                        *(u32x4*)(rowp + bj * HALF) = w; } }
            return;
        }
        const bool act = u.pn < 8;
#pragma unroll
        for (int ai = 0; ai < 2; ++ai)
#pragma unroll
            for (int m = 0; m < 4; ++m) { bf16_t* rowp = O + (size_t)(row0 + ai * HALF + m * 16) * ldc + col0;
                const float rs = __builtin_amdgcn_rsqf(pre[ai * 4 + m] * (1.f / 2048.f) + 1e-6f);
#pragma unroll
                for (int bj = 0; bj < 2; ++bj) { f32x4 v0 = acc[ai][bj][m][0] * rs, v1 = acc[ai][bj][m][1] * rs;
                    if (act) { f32x2 a = gelu_pk((f32x2){v0[0], v0[1]}), b = gelu_pk((f32x2){v0[2], v0[3]}), c = gelu_pk((f32x2){v1[0], v1[1]}), d = gelu_pk((f32x2){v1[2], v1[3]});
                        v0 = (f32x4){a.x, a.y, b.x, b.y}; v1 = (f32x4){c.x, c.y, d.x, d.y}; }
                    u32x4 w; w.x = cvt_pk_bf16(v0[0], v0[1]); w.y = cvt_pk_bf16(v0[2], v0[3]); w.z = cvt_pk_bf16(v1[0], v1[1]); w.w = cvt_pk_bf16(v1[2], v1[3]);
                    *(u32x4*)(rowp + bj * HALF) = w; } }
    }
};
struct EpiRes {
    static constexpr bool PERM = true, AFTER_DRAIN = false;
    bf16_t* xb; float* outf; int ldc; float* rsq_out; int mtot; PG8_LAS float* xl;
    __device__ __forceinline__ int begin(const Unit& u) const { return u.pm; }
    __device__ __forceinline__ void preload(const Unit&, int, int, int, float (&pre)[8]) const {
#pragma unroll
        for (int i = 0; i < 8; ++i) pre[i] = 0.f;
    }
    __device__ __forceinline__ void operator()(const f32x4 (&acc)[2][2][4][2], const Unit& u, int wr, int wc, int fr, int fq, const float (&)[8]) const {
        const int col0 = u.pn * BM + wc * 32 + 8 * fq;
        u32x4 bx[2][4][2];
#pragma unroll
        for (int ai = 0; ai < 2; ++ai)
#pragma unroll
            for (int m = 0; m < 4; ++m)
#pragma unroll
                for (int bj = 0; bj < 2; ++bj) bx[ai][m][bj] = *(const u32x4*)(xb + (size_t)(u.pm * BM + ai * HALF + wr * 64 + m * 16 + fr) * ldc + col0 + bj * HALF);
        asm volatile("" ::: "memory");
#pragma unroll
        for (int ai = 0; ai < 2; ++ai)
#pragma unroll
            for (int m = 0; m < 4; ++m) { const int rl = ai * HALF + wr * 64 + m * 16 + fr; const size_t off = (size_t)(u.pm * BM + rl) * ldc + col0;
                float ss = 0.f;
#pragma unroll
                for (int bj = 0; bj < 2; ++bj) { const u32x4 b = bx[ai][m][bj];
                    f32x4 o0, o1;
                    o0[0] = __builtin_bit_cast(float, b.x << 16) + acc[ai][bj][m][0][0]; o0[1] = __builtin_bit_cast(float, b.x & 0xffff0000u) + acc[ai][bj][m][0][1];
                    o0[2] = __builtin_bit_cast(float, b.y << 16) + acc[ai][bj][m][0][2]; o0[3] = __builtin_bit_cast(float, b.y & 0xffff0000u) + acc[ai][bj][m][0][3];
                    o1[0] = __builtin_bit_cast(float, b.z << 16) + acc[ai][bj][m][1][0]; o1[1] = __builtin_bit_cast(float, b.z & 0xffff0000u) + acc[ai][bj][m][1][1];
                    o1[2] = __builtin_bit_cast(float, b.w << 16) + acc[ai][bj][m][1][2]; o1[3] = __builtin_bit_cast(float, b.w & 0xffff0000u) + acc[ai][bj][m][1][3];
                    if (outf) { *(f32x4*)(outf + off + bj * HALF) = o0; *(f32x4*)(outf + off + bj * HALF + 4) = o1; }
                    else { ss += ((o0[0] * o0[0] + o0[1] * o0[1]) + (o0[2] * o0[2] + o0[3] * o0[3])) + ((o1[0] * o1[0] + o1[1] * o1[1]) + (o1[2] * o1[2] + o1[3] * o1[3]));
                        u32x4 w; w.x = cvt_pk_bf16(o0[0], o0[1]); w.y = cvt_pk_bf16(o0[2], o0[3]); w.z = cvt_pk_bf16(o1[0], o1[1]); w.w = cvt_pk_bf16(o1[2], o1[3]); *(u32x4*)(xb + off + bj * HALF) = w; } }
                if (rsq_out) { ss += __shfl_xor(ss, 16); ss += __shfl_xor(ss, 32); if (fq == 0) xl[rl * 4 + wc] = ss; } }
        if (rsq_out) {
            asm volatile("s_waitcnt lgkmcnt(0)\n\ts_barrier" ::: "memory");
            const int t = ltid();
            if (t < BM) { const f32x4 p = *(const PG8_LAS f32x4*)(xl + 4 * t); rsq_out[(size_t)u.pn * mtot + u.pm * BM + t] = (p[0] + p[1]) + (p[2] + p[3]); }
        }
    }
};
struct EpiSwiGLU {
    static constexpr bool PERM = true, AFTER_DRAIN = false;
    bf16_t* O; int ldc; RowScale rsc;
    __device__ __forceinline__ int begin(const Unit& u) const { return rsc.begin(u); }
    __device__ __forceinline__ void preload(const Unit& u, int tab_pm, int wr, int fr, float (&pre)[8]) const { rsc.preload(u, tab_pm, wr, fr, pre); }
    __device__ __forceinline__ void operator()(const f32x4 (&acc)[2][2][4][2], const Unit& u, int wr, int wc, int fr, int fq, const float (&pre)[8]) const {
        const int row0 = u.pm * BM + wr * 64 + fr; const int col0 = u.pn * HALF + wc * 32 + 8 * fq;
#pragma unroll
        for (int ai = 0; ai < 2; ++ai)
#pragma unroll
            for (int m = 0; m < 4; ++m) { bf16_t* rowp = O + (size_t)(row0 + ai * HALF + m * 16) * ldc + col0;
                const float rs = __builtin_amdgcn_rsqf(pre[ai * 4 + m] * (1.f / 2048.f) + 1e-6f);
                const f32x4 g0 = acc[ai][0][m][0] * rs, g1 = acc[ai][0][m][1] * rs, u0 = acc[ai][1][m][0] * rs, u1 = acc[ai][1][m][1] * rs;
                u32x4 w; w.x = cvt_pk_bf16(silu_f(g0[0]) * u0[0], silu_f(g0[1]) * u0[1]); w.y = cvt_pk_bf16(silu_f(g0[2]) * u0[2], silu_f(g0[3]) * u0[3]);
                w.z = cvt_pk_bf16(silu_f(g1[0]) * u1[0], silu_f(g1[1]) * u1[1]); w.w = cvt_pk_bf16(silu_f(g1[2]) * u1[2], silu_f(g1[3]) * u1[3]);
                *(u32x4*)rowp = w; }
    }
};
template <class Epi, class Sched, bool ALIGN_EPI = false, bool SP2 = false>
__device__ __forceinline__ void gemm_phase(PG8_LAS unsigned char* lds, const Gemm g, const Sched& S, const Epi& E) {
    const int tid = ltid(), wid = __builtin_amdgcn_readfirstlane(tid >> 6), lane = tid & 63, wr = wid >> 2, wc = wid & 3, fr = lane & 15, fq = lane >> 4;
    const int K = g.K, nt = K / BK;
    unsigned voffA[2], voffB[2];
#pragma unroll
    for (int i = 0; i < 2; ++i) { int R, C; stage_rc(tid * 16 + i * 8192, R, C); const int Rb = Epi::PERM ? ((R & ~31) + perm32(R & 31)) : R;
        voffA[i] = (unsigned)(R * g.lda + C) * 2u; voffB[i] = (unsigned)(Rb * K + C) * 2u; }
    const size_t kstep = (size_t)(BK * 2);
    const size_t hstep = (size_t)HALF * K * 2;
    const size_t tstep = 2 * hstep;
    const size_t hstepA = (size_t)HALF * g.lda * 2, tstepA = 2 * hstepA;
    const unsigned ldsw = (unsigned)wid * 1024u;
    const int aoff = lds_byte(wr * 64 + fr, fq * 8), boff = lds_byte(wc * 32 + fr, fq * 8);
#define PG8_SA(b, h) (((b) * 2 + (h)) * HTB)
#define PG8_SB(b, h) ((4 + (b) * 2 + (h)) * HTB)
#define PG8_STAGE(bufoff, gbase, voff) do { _Pragma("unroll") for (int _i = 0; _i < 2; ++_i) \
        __builtin_amdgcn_global_load_lds((const unsigned*)((const char*)(gbase) + (voff)[_i]), (PG8_LAS unsigned*)(lds + (bufoff) + ldsw + _i * 8192), 16, 0, 0); } while (0)
#define PG8_LDA(dst, b, h) do { _Pragma("unroll") for (int m = 0; m < 4; ++m) _Pragma("unroll") for (int k = 0; k < 2; ++k) dst[m][k] = *(const PG8_LAS bf16x8*)(lds + PG8_SA(b, h) + aoff + m * 2048 + k * 1024); } while (0)
#define PG8_LDB(dst, b, h) do { _Pragma("unroll") for (int n = 0; n < 2; ++n) _Pragma("unroll") for (int k = 0; k < 2; ++k) dst[n][k] = *(const PG8_LAS bf16x8*)(lds + PG8_SB(b, h) + boff + n * 2048 + k * 1024); } while (0)
#define PG8_MMA(ai, bj, At, Bt) do { __builtin_amdgcn_s_setprio(1); _Pragma("unroll") for (int m = 0; m < 4; ++m) _Pragma("unroll") for (int n = 0; n < 2; ++n) _Pragma("unroll") for (int k = 0; k < 2; ++k) \
        acc[ai][bj][m][n] = __builtin_amdgcn_mfma_f32_16x16x32_bf16(Bt[n][k], At[m][k], acc[ai][bj][m][n], 0, 0, 0); __builtin_amdgcn_s_setprio(0); } while (0)
#define PG8_WAIT_V(n) asm volatile("s_waitcnt vmcnt(" #n ")" ::: "memory")
#define PG8_WAIT_L(n) asm volatile("s_waitcnt lgkmcnt(" #n ")" ::: "memory")
#define PG8_BAR __builtin_amdgcn_s_barrier()
#define PG8_SCHED __builtin_amdgcn_sched_barrier(0)
    Unit cur, nxt; int ui = 0;
    if (!S.next(0, cur)) return;
    float pre[8], preN[8];
    const int tab_pm = E.begin(cur);
    E.preload(cur, tab_pm, wr, fr, pre);
    f32x4 acc[2][2][4][2];
#pragma unroll
    for (int a = 0; a < 2; ++a)
#pragma unroll
        for (int b = 0; b < 2; ++b)
#pragma unroll
            for (int m = 0; m < 4; ++m)
#pragma unroll
                for (int n = 0; n < 2; ++n) acc[a][b][m][n] = (f32x4){0.f, 0.f, 0.f, 0.f};
    bf16x8 At[4][2], B0[2][2], B1[2][2];
    const char* cA = (const char*)g.A + (size_t)cur.pm * tstepA; const char* cB = (const char*)g.Bt + (size_t)cur.pn * tstep;
    S.a_ready(cur);
    if constexpr (SP2) {
        PG8_STAGE(PG8_SB(0, 0), cB, voffB); PG8_STAGE(PG8_SB(0, 1), cB + hstep, voffB); PG8_STAGE(PG8_SA(0, 0), cA, voffA); PG8_STAGE(PG8_SA(0, 1), cA + hstepA, voffA);
        if (wr == 1) PG8_BAR;
        PG8_WAIT_V(2); PG8_BAR;
        PG8_STAGE(PG8_SB(1, 0), cB + kstep, voffB); PG8_STAGE(PG8_SA(1, 0), cA + kstep, voffA); PG8_STAGE(PG8_SB(1, 1), cB + hstep + kstep, voffB);
        PG8_WAIT_V(6); PG8_BAR;
    } else {
        PG8_STAGE(PG8_SB(0, 0), cB, voffB); PG8_STAGE(PG8_SA(0, 0), cA, voffA); PG8_STAGE(PG8_SB(0, 1), cB + hstep, voffB); PG8_STAGE(PG8_SA(0, 1), cA + hstepA, voffA);
        if (wr == 1) PG8_BAR;
        PG8_WAIT_V(4); PG8_BAR;
        PG8_STAGE(PG8_SB(1, 0), cB + kstep, voffB); PG8_STAGE(PG8_SA(1, 0), cA + kstep, voffA); PG8_STAGE(PG8_SB(1, 1), cB + hstep + kstep, voffB);
        PG8_WAIT_V(6); PG8_BAR;
    }
    for (;;) {
        const bool has_next = S.next(ui + 1, nxt);
        const char* nA = has_next ? (const char*)g.A + (size_t)nxt.pm * tstepA : cA; const char* nB = has_next ? (const char*)g.Bt + (size_t)nxt.pn * tstep : cB;
        for (int t = 0; t < nt; t += 2) {
            const bool last = (t == nt - 2);
            const char* a1 = cA + (size_t)(t + 1) * kstep;
            const char* a2 = last ? nA : cA + (size_t)(t + 2) * kstep; const char* b2 = last ? nB : cB + (size_t)(t + 2) * kstep;
            const char* a3 = a2 + kstep; const char* b3 = b2 + kstep;
            if (last && has_next) S.a_ready(nxt);
            if constexpr (SP2) {
            PG8_LDB(B0, 0, 0); PG8_LDB(B1, 0, 1); PG8_SCHED; PG8_LDA(At, 0, 0); PG8_STAGE(PG8_SA(1, 1), a1 + hstepA, voffA);
            PG8_WAIT_V(8); PG8_WAIT_L(0); PG8_BAR; PG8_MMA(0, 0, At, B0); PG8_MMA(0, 1, At, B1); PG8_BAR; PG8_SCHED;
            PG8_LDA(At, 0, 1); PG8_STAGE(PG8_SB(0, 0), b2, voffB); PG8_STAGE(PG8_SB(0, 1), b2 + hstep, voffB); PG8_STAGE(PG8_SA(0, 0), a2, voffA);
            PG8_WAIT_V(8); PG8_WAIT_L(0); PG8_BAR; PG8_MMA(1, 0, At, B0); PG8_MMA(1, 1, At, B1); PG8_BAR; PG8_SCHED;
            PG8_LDB(B0, 1, 0); PG8_LDB(B1, 1, 1); PG8_SCHED; PG8_LDA(At, 1, 0); PG8_STAGE(PG8_SA(0, 1), a2 + hstepA, voffA);
            PG8_WAIT_V(8); PG8_WAIT_L(0); PG8_BAR; PG8_MMA(0, 0, At, B0); PG8_MMA(0, 1, At, B1); PG8_BAR; PG8_SCHED;
            PG8_LDA(At, 1, 1); PG8_STAGE(PG8_SB(1, 0), b3, voffB); PG8_STAGE(PG8_SB(1, 1), b3 + hstep, voffB); PG8_STAGE(PG8_SA(1, 0), a3, voffA);
            PG8_WAIT_V(8); PG8_WAIT_L(0); PG8_BAR; PG8_MMA(1, 0, At, B0); PG8_MMA(1, 1, At, B1); PG8_BAR; PG8_SCHED;
            } else {
            PG8_LDB(B0, 0, 0); PG8_SCHED; PG8_LDA(At, 0, 0); PG8_STAGE(PG8_SA(1, 1), a1 + hstepA, voffA);
            PG8_WAIT_L(8); PG8_BAR; PG8_WAIT_L(0); PG8_MMA(0, 0, At, B0); PG8_BAR; PG8_SCHED;
            PG8_LDB(B1, 0, 1); PG8_STAGE(PG8_SB(0, 0), b2, voffB);
            PG8_BAR; PG8_WAIT_L(0); PG8_MMA(0, 1, At, B1); PG8_BAR;
            PG8_LDA(At, 0, 1); PG8_STAGE(PG8_SA(0, 0), a2, voffA);
            PG8_BAR; PG8_WAIT_L(0); PG8_MMA(1, 0, At, B0); PG8_BAR; PG8_SCHED;
            PG8_STAGE(PG8_SB(0, 1), b2 + hstep, voffB);
            PG8_WAIT_V(6); PG8_BAR; PG8_MMA(1, 1, At, B1); PG8_BAR;
            PG8_LDB(B0, 1, 0); PG8_SCHED; PG8_LDA(At, 1, 0); PG8_STAGE(PG8_SA(0, 1), a2 + hstepA, voffA);
            PG8_WAIT_L(8); PG8_BAR; PG8_WAIT_L(0); PG8_MMA(0, 0, At, B0); PG8_BAR; PG8_SCHED;
            PG8_LDB(B1, 1, 1); PG8_STAGE(PG8_SB(1, 0), b3, voffB);
            PG8_BAR; PG8_WAIT_L(0); PG8_MMA(0, 1, At, B1); PG8_BAR;
            PG8_LDA(At, 1, 1); PG8_STAGE(PG8_SA(1, 0), a3, voffA);
            PG8_BAR; PG8_WAIT_L(0); PG8_MMA(1, 0, At, B0); PG8_BAR; PG8_SCHED;
            PG8_STAGE(PG8_SB(1, 1), b3 + hstep, voffB);
            PG8_WAIT_V(6); PG8_BAR; PG8_MMA(1, 1, At, B1); PG8_BAR;
            }
        }
        if constexpr (ALIGN_EPI) { if (wr == 0) PG8_BAR; }
        if (has_next) E.preload(nxt, tab_pm, wr, fr, preN);
        if constexpr (!Epi::AFTER_DRAIN) { E(acc, cur, wr, wc, fr, fq, pre); S.done(cur); }
#pragma unroll
        for (int i_ = 0; i_ < 8; ++i_) pre[i_] = preN[i_];
        if (!has_next) break;
#pragma unroll
        for (int a = 0; a < 2; ++a)
#pragma unroll
            for (int b = 0; b < 2; ++b)
#pragma unroll
                for (int m = 0; m < 4; ++m)
#pragma unroll
                    for (int n = 0; n < 2; ++n) acc[a][b][m][n] = (f32x4){0.f, 0.f, 0.f, 0.f};
        cur = nxt; cA = nA; cB = nB; ++ui;
        if constexpr (ALIGN_EPI) { if (wr == 1) PG8_BAR; }
    }
    PG8_WAIT_V(0);
    if constexpr (!ALIGN_EPI) { if (wr == 0) PG8_BAR; }
    PG8_BAR;
    if constexpr (Epi::AFTER_DRAIN) { E.fused(acc, cur, wr, wc, fr, fq, lds, wid, lane); S.done(cur); }
#undef PG8_SA
#undef PG8_SB
#undef PG8_STAGE
#undef PG8_LDA
#undef PG8_LDB
#undef PG8_MMA
#undef PG8_WAIT_V
#undef PG8_WAIT_L
#undef PG8_BAR
#undef PG8_SCHED
}
}
namespace swa {
constexpr int D = 128;
constexpr float THR = 8.f;
constexpr bool WSKIP = true;
constexpr float SCALE = 0.08838834764831845f;
constexpr int NW = 8, QBLK = 32, KVBLK = 64, QB = NW * QBLK;
constexpr int SHM_V = KVBLK * D * 2, SHM_K = KVBLK * D * 2;
constexpr int LDS_BYTES = 2 * SHM_V + 2 * SHM_K + NW * 64 * 4;
using bf16 = __hip_bfloat16;
typedef short bf16x8 __attribute__((ext_vector_type(8)));
typedef short s16x4 __attribute__((ext_vector_type(4)));
typedef float f32x16 __attribute__((ext_vector_type(16)));
typedef float f32x4 __attribute__((ext_vector_type(4)));
typedef unsigned u32x4 __attribute__((ext_vector_type(4)));
template <class A, class Bt> struct same_t { static constexpr bool v = false; };
template <class A> struct same_t<A, A> { static constexpr bool v = true; };

#define KSWZ(row, colB) ((row) * 256 + ((colB) ^ (((row) & 7) << 4)))
#define SBAR() __builtin_amdgcn_sched_barrier(0)
__device__ __forceinline__ int v_st(int k, int c) { const int kk = (k & ~0xC) | ((k & 4) << 1) | ((k & 8) >> 1); return ((kk >> 3) * 4 + (c >> 5)) * 512 + ((kk & 7) * 32 + (c & 31)) * 2; }
__device__ __forceinline__ int v_rd_base(int lane) { return ((lane & 3) << 3) | (((lane >> 2) & 3) << 6) | (((lane >> 4) & 1) << 5) | (((lane >> 5) & 1) << 8); }
constexpr int v_rd_off(int d0, int ks, int half) { return d0 * 512 + ks * 4096 + half * 2048; }
__device__ __forceinline__ int crow(int r, int hi) { return (r & 3) + 8 * (r >> 2) + 4 * hi; }
__device__ __forceinline__ unsigned cvtpk(float lo, float hi) {
    unsigned r; asm volatile("v_cvt_pk_bf16_f32 %0, %1, %2" : "=v"(r) : "v"(lo), "v"(hi)); return r;
}
__device__ __forceinline__ bf16x8 pack8(f32x4 a, f32x4 b) {
    u32x4 w = {cvtpk(a[0], a[1]), cvtpk(a[2], a[3]), cvtpk(b[0], b[1]), cvtpk(b[2], b[3])};
    return *reinterpret_cast<bf16x8*>(&w);
}
template <class T> __device__ __forceinline__ bf16x8 load8(const T* p) {
    if constexpr (same_t<T, float>::v) { return pack8(*(const f32x4*)p, *(const f32x4*)(p + 4)); }
    else { return *reinterpret_cast<const bf16x8*>(p); }
}
__device__ __forceinline__ void mask_tile(f32x16& p0, f32x16& p1, int dq, unsigned W) {
    const float NEG = -__builtin_inff();
#pragma unroll
    for (int r = 0; r < 16; ++r) {
        const int c = (r & 3) + 8 * (r >> 2);
        if ((unsigned)(dq - c) >= W) p0[r] = NEG;
        if ((unsigned)(dq - c - 32) >= W) p1[r] = NEG;
    }
}
__device__ __forceinline__ void partialSM(f32x16& p0, f32x16& p1, float& m_reg, float& mn, float& alpha) {
    float pmax = p0[0]; for (int r = 1; r < 16; ++r) pmax = fmaxf(pmax, p0[r]); for (int r = 0; r < 16; ++r) pmax = fmaxf(pmax, p1[r]);
    { auto rr = __builtin_amdgcn_permlane32_swap(__float_as_uint(pmax), __float_as_uint(pmax), false, false);
      pmax = fmaxf(__uint_as_float(rr[0]), __uint_as_float(rr[1])); }
    constexpr float C2 = 1.4426950408889634f * SCALE;
    if (__builtin_expect(__all((pmax - m_reg) * SCALE <= THR), 1)) { mn = m_reg; alpha = 1.f; }
    else { mn = fmaxf(m_reg, pmax); alpha = __builtin_amdgcn_exp2f((m_reg - mn) * C2); m_reg = mn; }
    const float mnL = -mn * C2;
    for (int r = 0; r < 16; ++r) p0[r] = fmaf(p0[r], C2, mnL); for (int r = 0; r < 16; ++r) p1[r] = fmaf(p1[r], C2, mnL);
    for (int r = 0; r < 16; ++r) p0[r] = __builtin_amdgcn_exp2f(p0[r]);
}
__device__ __forceinline__ void finishSM(f32x16& p0, f32x16& p1, float alpha, float& l_reg, bf16x8& pa0, bf16x8& pa1, bf16x8& pa2, bf16x8& pa3) {
    for (int r = 0; r < 16; ++r) p1[r] = __builtin_amdgcn_exp2f(p1[r]);
    float ps = 0; for (int r = 0; r < 16; ++r) ps += p0[r]; for (int r = 0; r < 16; ++r) ps += p1[r];
    { auto rr = __builtin_amdgcn_permlane32_swap(__float_as_uint(ps), __float_as_uint(ps), false, false);
      ps = __uint_as_float(rr[0]) + __uint_as_float(rr[1]); }
    l_reg = l_reg * alpha + ps;
#define PK4(P, B_, OUT) do { unsigned a0 = cvtpk(P[B_+0], P[B_+1]), a1 = cvtpk(P[B_+2], P[B_+3]);                          \
        unsigned b0 = cvtpk(P[B_+4], P[B_+5]), b1 = cvtpk(P[B_+6], P[B_+7]);                                             \
        auto r0 = __builtin_amdgcn_permlane32_swap(a0, b0, false, false); auto r1 = __builtin_amdgcn_permlane32_swap(a1, b1, false, false); \
        u32x4 w = {r0[0], r1[0], r0[1], r1[1]}; OUT = *reinterpret_cast<bf16x8*>(&w); } while (0)
    PK4(p0, 0, pa0); PK4(p0, 8, pa1); PK4(p1, 0, pa2); PK4(p1, 8, pa3);
#undef PK4
}
template <int KB, bool SK>
__device__ __forceinline__ void qkt(f32x16& p0, f32x16& p1, const char* K_lds, int r32, int hi, const bf16x8* qr, bool act) {
    if (SK && !act) { const float NEG = -__builtin_inff();
#pragma unroll
        for (int r = 0; r < 16; ++r) { p0[r] = NEG; p1[r] = NEG; } return; }
    p0 = f32x16{}; p1 = f32x16{};
    const char* kb[4];
#pragma unroll
    for (int dd = 0; dd < 4; ++dd) kb[dd] = K_lds + KB * SHM_K + KSWZ(r32, (dd * 16 + hi * 8) * 2);
#pragma unroll
    for (int d0 = 0; d0 < 8; ++d0) { const char* a = kb[d0 & 3] + (d0 >> 2) * 128;
        bf16x8 b0 = *reinterpret_cast<const bf16x8*>(a);
        bf16x8 b1 = *reinterpret_cast<const bf16x8*>(a + 32 * 256);
        p0 = __builtin_amdgcn_mfma_f32_32x32x16_bf16(b0, qr[d0], p0, 0, 0, 0);
        p1 = __builtin_amdgcn_mfma_f32_32x32x16_bf16(b1, qr[d0], p1, 0, 0, 0); }
}
template <int VB, bool SK>
__device__ __forceinline__ void pv_tile(f32x16* o, int vb0, bf16x8 pa0, bf16x8 pa1, bf16x8 pa2, bf16x8 pa3, bool act) {
    if (SK && !act) return;
#define TRRD(dst, off) asm volatile("ds_read_b64_tr_b16 %0, %1 offset:%2" : "=&v"(dst) : "v"(vb0), "i"(off) : "memory")
#define PV_D0(d0) do { s16x4 l0, l1, l2, l3, h0, h1, h2, h3; constexpr int b_ = VB * SHM_V + v_rd_off(d0, 0, 0);     \
        TRRD(l0, b_); TRRD(h0, b_ + 2048); TRRD(l1, b_ + 4096); TRRD(h1, b_ + 6144); TRRD(l2, b_ + 8192); TRRD(h2, b_ + 10240); TRRD(l3, b_ + 12288); TRRD(h3, b_ + 14336); \
        asm volatile("s_waitcnt lgkmcnt(0)" ::: "memory"); SBAR();                 \
        o[d0] = __builtin_amdgcn_mfma_f32_32x32x16_bf16(pa0, (bf16x8){l0[0], l0[1], l0[2], l0[3], h0[0], h0[1], h0[2], h0[3]}, o[d0], 0, 0, 0);   \
        o[d0] = __builtin_amdgcn_mfma_f32_32x32x16_bf16(pa1, (bf16x8){l1[0], l1[1], l1[2], l1[3], h1[0], h1[1], h1[2], h1[3]}, o[d0], 0, 0, 0);   \
        o[d0] = __builtin_amdgcn_mfma_f32_32x32x16_bf16(pa2, (bf16x8){l2[0], l2[1], l2[2], l2[3], h2[0], h2[1], h2[2], h2[3]}, o[d0], 0, 0, 0);   \
        o[d0] = __builtin_amdgcn_mfma_f32_32x32x16_bf16(pa3, (bf16x8){l3[0], l3[1], l3[2], l3[3], h3[0], h3[1], h3[2], h3[3]}, o[d0], 0, 0, 0); } while (0)
    PV_D0(0); PV_D0(1); PV_D0(2); PV_D0(3);
#undef PV_D0
#undef TRRD
}

template <class TIn, class TOut> struct BlockRef { const TIn* Q; const TIn* K; const TIn* V; TOut* O; float* L; int P0; int pitch; int lpitch; };
template <class TIn> struct Seam {
    bf16x8 qr[8];
    bf16x8 st_v0, st_v1, st_k0, st_k1; f32x4 sf0, sf1, sf2, sf3;
    f32x4 tq[16];
};
__device__ __forceinline__ int swa_jlo(int P0, int W) { const int lowk = P0 - W + 1; return lowk > 0 ? lowk / KVBLK : 0; }
#define ROWP(p, k0, rr, pt) ((p) + (size_t)((k0) + (rr)) * (size_t)(pt) + sc)
#define ROW(p, k0, rr) ROWP(p, k0, rr, rowp_)
#define VMW() asm volatile("s_waitcnt vmcnt(0)" ::: "memory")
#define VMWN(n) asm volatile("s_waitcnt vmcnt(%0)" :: "i"(n) : "memory")
#define SLOAD_HP(Kp, Vp, k0, pt) do { S.st_v0 = load8<TIn>(ROWP(Vp, k0, sr, pt)); S.st_v1 = load8<TIn>(ROWP(Vp, k0, 32 + sr, pt));              \
                         S.st_k0 = load8<TIn>(ROWP(Kp, k0, sr, pt)); S.st_k1 = load8<TIn>(ROWP(Kp, k0, 32 + sr, pt)); } while (0)
#define SLOAD_H(Kp, Vp, k0) SLOAD_HP(Kp, Vp, k0, rowp_)
#define SWRITE_HK(bf) do { *(bf16x8*)(K_lds + (bf) * SHM_K + kws) = S.st_k0; *(bf16x8*)(K_lds + (bf) * SHM_K + kws + 32 * 256) = S.st_k1; } while (0)
#define SWRITE_HV(bf) do { *(bf16x8*)(V_lds + (bf) * SHM_V + vst0) = S.st_v0; *(bf16x8*)(V_lds + (bf) * SHM_V + vst1) = S.st_v1; } while (0)
#define SWRITE_H(bf) do { SWRITE_HV(bf); SWRITE_HK(bf); } while (0)
#define SLOAD_F(p, k0) do { S.sf0 = *(const f32x4*)ROW(p, k0, sr); S.sf1 = *(const f32x4*)(ROW(p, k0, sr) + 4);                \
                            S.sf2 = *(const f32x4*)ROW(p, k0, 32 + sr); S.sf3 = *(const f32x4*)(ROW(p, k0, 32 + sr) + 4); } while (0)
#define SWRITE_KF(bf) do { *(bf16x8*)(K_lds + (bf) * SHM_K + kws) = pack8(S.sf0, S.sf1); *(bf16x8*)(K_lds + (bf) * SHM_K + kws + 32 * 256) = pack8(S.sf2, S.sf3); } while (0)
#define SWRITE_VF(bf) do { *(bf16x8*)(V_lds + (bf) * SHM_V + vst0) = pack8(S.sf0, S.sf1); *(bf16x8*)(V_lds + (bf) * SHM_V + vst1) = pack8(S.sf2, S.sf3); } while (0)
template <class TIn, class TOut>
__device__ __forceinline__ void causal_swa_prime(const BlockRef<TIn, TOut>& cur, int W, char* lds, Seam<TIn>& S) {
    constexpr bool F32 = same_t<TIn, float>::v;
    const int tid = ltid(), wid = __builtin_amdgcn_readfirstlane(tid >> 6), lane = tid & 63, r32 = lane & 31, hi = lane >> 5;
    const int sr = tid >> 4, sc = (tid & 15) * 8, kws = KSWZ(sr, sc * 2); char* K_lds = lds + 2 * SHM_V;
    const int kb0 = swa_jlo(cur.P0, W) * KVBLK; const int rowp_ = cur.pitch;
    for (int d0 = 0; d0 < 8; ++d0) S.qr[d0] = load8<TIn>(cur.Q + (size_t)(wid * QBLK + r32) * (size_t)cur.pitch + d0 * 16 + hi * 8);
    if constexpr (F32) { SLOAD_F((const float*)cur.K, kb0); VMW(); SWRITE_KF(0); SBAR(); SLOAD_F((const float*)cur.V, kb0); }
    else { SLOAD_H(cur.K, cur.V, kb0); VMW(); SWRITE_HK(0); }
    __syncthreads();
}
template <class TIn, class TOut>
__device__ __forceinline__ void causal_swa_block(const BlockRef<TIn, TOut>& cur, const BlockRef<TIn, TOut>& nxt, int skv, int W, char* lds, Seam<TIn>& S) {
    constexpr bool F32 = same_t<TIn, float>::v;
    const int tid = ltid(), wid = __builtin_amdgcn_readfirstlane(tid >> 6), lane = tid & 63, r32 = lane & 31, hi = lane >> 5;
    const int j_lo = swa_jlo(cur.P0, W); const int rowp_ = cur.pitch;
    int j_hi = (cur.P0 + QB - 1) / KVBLK + 1; if (j_hi > skv / KVBLK) j_hi = skv / KVBLK;
    const int NT = j_hi - j_lo;
    const int kbn = swa_jlo(nxt.P0, W) * KVBLK;
    const int qlo = cur.P0 + wid * QBLK, qm = qlo + r32 - 4 * hi;
    char* V_lds = lds; char* K_lds = lds + 2 * SHM_V;
    float* ws = (float*)(lds + 2 * SHM_V + 2 * SHM_K) + wid * 64; float* li_l = ws, * al_l = ws + 32;
    float m_reg = -1e30f, l_reg = 0; f32x16 o[4] = {};
    const int sr = tid >> 4, sc = (tid & 15) * 8, vst0 = v_st(sr, sc), vst1 = v_st(32 + sr, sc), kws = KSWZ(sr, sc * 2);
    const int vb0 = (int)(uintptr_t)V_lds + v_rd_base(lane);
    const TIn* Kh = cur.K; const TIn* Vh = cur.V;
#define RESC(a) do { if (__any((a) < 1.f)) { if (hi == 0) al_l[r32] = (a); asm volatile("s_waitcnt lgkmcnt(0)" ::: "memory");              \
                     for (int d_ = 0; d_ < 4; ++d_) for (int r = 0; r < 16; ++r) o[d_][r] *= al_l[crow(r, hi)]; } } while (0)
#define KBASE(t) ((j_lo + (t)) * KVBLK)
#define ACT(t) (KBASE(t) <= qlo + QBLK - 1 && KBASE(t) + KVBLK - 1 >= qlo - W + 1)
#define MASKT(P0_, P1_, t) do { const int kb_ = KBASE(t); if ((!SK || ACT(t)) && (kb_ + KVBLK - 1 > qlo || kb_ <= qlo + QBLK - 1 - W)) mask_tile(P0_, P1_, qm - kb_, (unsigned)W); } while (0)
    constexpr int NQL = F32 ? 16 : 8;
    constexpr bool SK = WSKIP && !F32;
#define SEAM_K0() do { VMWN(NQL); if constexpr (F32) { SWRITE_KF(0); SBAR(); SLOAD_F((const float*)nxt.V, kbn); } else { SWRITE_HK(0); } SBAR(); } while (0)
    f32x16 pA0, pA1, pB0, pB1; float mnA, mnB, alA, alB; bf16x8 pa0, pa1, pa2, pa3;
    if constexpr (F32) { VMW(); SWRITE_VF(0); SBAR(); } else { SWRITE_HV(0); SBAR(); }
    if (NT > 1) { if constexpr (F32) SLOAD_F((const float*)Kh, KBASE(1)); else SLOAD_H(Kh, Vh, KBASE(1)); }
    SBAR(); qkt<0, SK>(pA0, pA1, K_lds, r32, hi, S.qr, ACT(0));
    if constexpr (F32) { if (NT > 1) { VMW(); SWRITE_KF(1); SBAR(); SLOAD_F((const float*)Vh, KBASE(1)); } }
    MASKT(pA0, pA1, 0); partialSM(pA0, pA1, m_reg, mnA, alA);
    if (NT > 1) { VMW(); if constexpr (F32) { SWRITE_VF(1); SBAR(); if (NT > 2) SLOAD_F((const float*)Kh, KBASE(2)); } else SWRITE_H(1); }
    __syncthreads();
#define HALF_STEP(PX0, PX1, mnX, alX, PY0, PY1, alY, t, KB, VB, SB) do {                                                      \
        SBAR(); qkt<KB, SK>(PX0, PX1, K_lds, r32, hi, S.qr, ACT(t));                                             \
        finishSM(PY0, PY1, alY, l_reg, pa0, pa1, pa2, pa3); SBAR();                                                           \
        if ((t) + 1 < NT) { if constexpr (F32) { VMW(); SWRITE_KF(SB); SBAR(); SLOAD_F((const float*)Vh, KBASE((t) + 1)); }  \
                            else { SLOAD_H(Kh, Vh, KBASE((t) + 1)); } SBAR(); }                                               \
        pv_tile<VB, SK>(o, vb0, pa0, pa1, pa2, pa3, ACT((t) - 1)); MASKT(PX0, PX1, (t)); partialSM(PX0, PX1, m_reg, mnX, alX);                                        \
        __syncthreads();                                                                                                      \
        if ((t) + 1 < NT) { VMW(); if constexpr (F32) { SWRITE_VF(SB); SBAR(); if ((t) + 2 < NT) SLOAD_F((const float*)Kh, KBASE((t) + 2)); } \
                            else { SWRITE_H(SB); } }                                                                          \
        RESC(alX); __syncthreads(); } while (0)
    for (int t = 1; t + 1 < NT; t += 2) {
        HALF_STEP(pB0, pB1, mnB, alB, pA0, pA1, alA, t, 1, 0, 0);
        HALF_STEP(pA0, pA1, mnA, alA, pB0, pB1, alB, t + 1, 0, 1, 1);
    }
    const bool even = (NT & 1) == 0;
    if (even) { SBAR(); qkt<1, SK>(pB0, pB1, K_lds, r32, hi, S.qr, ACT(NT - 1)); SBAR(); }
#define QROW(e) (nxt.Q + (size_t)(wid * QBLK + r32) * (size_t)nxt.pitch + ((e) >> 1) * 16 + hi * 8 + ((e) & 1) * 4)
    if constexpr (F32) { SLOAD_F((const float*)nxt.K, kbn); SBAR();
#pragma unroll
        for (int e = 0; e < 8; ++e) S.tq[e] = *(const f32x4*)QROW(e); }
    else { SLOAD_HP(nxt.K, nxt.V, kbn, nxt.pitch); SBAR();
#pragma unroll
        for (int d0 = 0; d0 < 8; ++d0) S.qr[d0] = load8<TIn>(nxt.Q + (size_t)(wid * QBLK + r32) * (size_t)nxt.pitch + d0 * 16 + hi * 8); }
    SBAR();
    finishSM(pA0, pA1, alA, l_reg, pa0, pa1, pa2, pa3); SBAR();
    if constexpr (F32) {
#pragma unroll
        for (int e = 8; e < 16; ++e) S.tq[e] = *(const f32x4*)QROW(e); SBAR(); }
#undef QROW
    pv_tile<0, SK>(o, vb0, pa0, pa1, pa2, pa3, ACT(even ? NT - 2 : NT - 1));
    if (even) { MASKT(pB0, pB1, NT - 1); partialSM(pB0, pB1, m_reg, mnB, alB); __syncthreads(); RESC(alB);
        finishSM(pB0, pB1, alB, l_reg, pa0, pa1, pa2, pa3); SBAR(); pv_tile<1, SK>(o, vb0, pa0, pa1, pa2, pa3, ACT(NT - 1)); }
    SBAR(); SEAM_K0();
    if (hi == 0) { li_l[r32] = l_reg; cur.L[(size_t)(wid * QBLK + r32) * (size_t)cur.lpitch] = m_reg * SCALE + __builtin_amdgcn_logf(l_reg) * 0.6931471805599453f; }
    asm volatile("s_waitcnt lgkmcnt(0)" ::: "memory");
    float rli[16];
#pragma unroll
    for (int r = 0; r < 16; ++r) rli[r] = __builtin_amdgcn_rcpf(li_l[crow(r, hi)]);
    TOut* Ow = cur.O + (size_t)(wid * QBLK) * (size_t)cur.pitch;
#pragma unroll
    for (int r = 0; r < 16; ++r) { const int orow = crow(r, hi);
#pragma unroll
        for (int d0 = 0; d0 < 4; ++d0) { const float v = o[d0][r] * rli[r];
            if constexpr (same_t<TOut, float>::v) { Ow[(size_t)orow * (size_t)cur.pitch + d0 * 32 + r32] = v; }
            else { const float vn = __shfl_xor(v, 1);
                   if ((r32 & 1) == 0) *(unsigned*)(Ow + (size_t)orow * (size_t)cur.pitch + d0 * 32 + r32) = cvtpk(v, vn); } } }
    if constexpr (F32) {
#pragma unroll
        for (int d0 = 0; d0 < 8; ++d0) S.qr[d0] = pack8(S.tq[2 * d0], S.tq[2 * d0 + 1]); }
    __syncthreads();
#undef RESC
#undef KBASE
#undef ACT
#undef MASKT
#undef SEAM_K0
#undef HALF_STEP
}
#undef ROW
#undef ROWP
#undef SLOAD_HP
#undef VMW
#undef VMWN
#undef SLOAD_H
#undef SWRITE_HK
#undef SWRITE_HV
#undef SWRITE_H
#undef SLOAD_F
#undef SWRITE_KF
#undef SWRITE_VF
}
#ifndef ONE_LAUNCH
#define ONE_LAUNCH 1
#endif
#ifndef PROBE_SKIP
#define PROBE_SKIP 0
#endif
#ifndef NPASS
#define NPASS 1
#endif
#ifndef PROBE_DUP_PROLOGUE
#define PROBE_DUP_PROLOGUE 0
#endif
constexpr int NBATCH = 4, SEQ = 4096, DM = 2048, M = NBATCH * SEQ, INW = 7168, DFF = 5632, DEPTH = 2;
constexpr int C_Q = 2048, C_K = 5120, C_V = 6144;
constexpr float EPS = 1e-6f;
constexpr int NWAVES = 8;
constexpr size_t MiB = 1u << 20;
constexpr size_t WS_CTL = 0, CTL_ZERO_BYTES = 1 * MiB;
constexpr int CW_BAR = 4096;
constexpr size_t WS_RSQ = 5 * MiB;
constexpr int RT_OFF = 131072 + 1024 + 8192;
constexpr int XL_OFF = 131072 + 1024;
constexpr int MISC_OFF = 131072 + 320;
constexpr size_t WS_ROPE = 1 * MiB;
constexpr size_t WS_LSE = 3 * MiB;
constexpr size_t WS_W = 8 * MiB;
constexpr size_t W_IN_OFF = 0, W_OUT_OFF = 28 * MiB, W_GU_OFF = 36 * MiB, W_DN_OFF = 80 * MiB, W_LAYER = 102 * MiB;
constexpr size_t WS_XN = WS_W + DEPTH * W_LAYER;
constexpr size_t WS_Z = WS_XN + 64 * MiB;
constexpr size_t WS_END = WS_Z + 224 * MiB;
static_assert((size_t)INW * DM * 2 == 28 * MiB && (size_t)DM * DM * 2 == 8 * MiB && (size_t)2 * DFF * DM * 2 == 44 * MiB && (size_t)DM * DFF * 2 == 22 * MiB, "weight map");
static_assert((size_t)M * DM * 2 == 64 * MiB && (size_t)M * INW * 2 == 224 * MiB && (size_t)M * DFF * 2 <= 224 * MiB, "activation map");
constexpr int LDS_BYTES = 147456;

#define LAS __attribute__((address_space(3)))
typedef unsigned short bf16_t;
typedef unsigned u32x4 __attribute__((ext_vector_type(4)));
typedef unsigned u32x2 __attribute__((ext_vector_type(2)));
typedef float f32x4 __attribute__((ext_vector_type(4)));
typedef short bf16x8 __attribute__((ext_vector_type(8)));
#define LDS_WAIT() asm volatile("s_waitcnt lgkmcnt(0)" ::: "memory")

__device__ __forceinline__ unsigned f2bf(float f) { unsigned u = __builtin_bit_cast(unsigned, f); return (u + 0x7fffu + ((u >> 16) & 1u)) >> 16; }
__device__ __forceinline__ unsigned pk2(float lo, float hi) { return pg8::cvt_pk_bf16(lo, hi); }
__device__ __forceinline__ float bf_lo(unsigned w) { return __builtin_bit_cast(float, w << 16); }
__device__ __forceinline__ float bf_hi(unsigned w) { return __builtin_bit_cast(float, w & 0xffff0000u); }
__device__ __forceinline__ float wave_sum(float v) {
#pragma unroll
    for (int o = 1; o < 64; o <<= 1) v += __shfl_xor(v, o);
    return v;
}

struct Args { const float* in[16]; float* out; unsigned char* ws; int ph_lo, ph_hi; };

__device__ __forceinline__ void transpose_item(const float* W, int K, int N, bf16_t* WT, int mode, const float* kscale, LAS float* scr, int item, int lane) {
    const int nblk = N / 32, kb = item / nblk, nb = item % nblk, k0 = 64 * kb, n0 = 32 * nb;
    const int drow = (mode == 0 || mode == 3) ? n0 : ((n0 >> 7) * 256 + (n0 & 127) + (mode == 2 ? 128 : 0));
    f32x4 t[8];
#pragma unroll
    for (int i = 0; i < 8; ++i) t[i] = *(const f32x4*)(W + (size_t)(k0 + 8 * i + (lane >> 3)) * N + n0 + 4 * (lane & 7));
#pragma unroll
    for (int i = 0; i < 8; ++i) { const int kk = 8 * i + (lane >> 3); const float sc = kscale ? kscale[k0 + kk] : 1.f; LAS float* d = scr + kk * 33 + 4 * (lane & 7);
        d[0] = t[i][0] * sc; d[1] = t[i][1] * sc; d[2] = t[i][2] * sc; d[3] = t[i][3] * sc; }
    LDS_WAIT(); asm volatile("" ::: "memory");
    const int c = lane & 7;
#pragma unroll
    for (int j = 0; j < 4; ++j) { const int n = (lane >> 3) + 8 * j; const LAS float* s = scr + (8 * c) * 33 + n;
        int dn = n;
        if (mode == 3 && n0 >= 2048 && n0 < 6144) { const int d = (n0 & 127) + n; dn = ((d >> 4) & 3) * 32 + ((d >> 2) & 3) * 8 + (d >> 6) * 4 + (d & 3) - (n0 & 127); }
        u32x4 o; o.x = pk2(s[0 * 33], s[1 * 33]); o.y = pk2(s[2 * 33], s[3 * 33]); o.z = pk2(s[4 * 33], s[5 * 33]); o.w = pk2(s[6 * 33], s[7 * 33]);
        *(u32x4*)(WT + (size_t)(drow + dn) * K + k0 + 8 * c) = o; }
    LDS_WAIT(); asm volatile("" ::: "memory");
}
__device__ __forceinline__ void convert_rows(const float* X, bf16_t* out, float* rsq, int gw, int ngw, int lane) {
    for (int m = gw; m < M; m += ngw) {
        const f32x4* xr = (const f32x4*)(X + (size_t)m * DM) + lane;
        f32x4 v[8]; float s = 0.f;
#pragma unroll
        for (int j = 0; j < 8; ++j) { v[j] = xr[64 * j]; s += (v[j].x * v[j].x + v[j].y * v[j].y) + (v[j].z * v[j].z + v[j].w * v[j].w); }
        s = wave_sum(s); if (lane == 0) rsq[m] = s;
        u32x2* o8 = (u32x2*)(out + (size_t)m * DM) + lane;
#pragma unroll
        for (int j = 0; j < 8; ++j) { u32x2 w; w.x = pk2(v[j].x, v[j].y); w.y = pk2(v[j].z, v[j].w); o8[64 * j] = w; }
    }
}
__device__ __forceinline__ void qk_prep(bf16_t* Z, const float* qn, const float* kn, const float* rope, int gw, int ngw, int lane) {
    const int i4 = 4 * (lane & 15);
    const f32x4 gq1 = *(const f32x4*)(qn + i4), gq2 = *(const f32x4*)(qn + 64 + i4), gk1 = *(const f32x4*)(kn + i4), gk2 = *(const f32x4*)(kn + 64 + i4);
    for (int it = gw; it < M * 8; it += 4 * ngw) {
        bf16_t* p[4]; u32x2 a[4], b[4]; f32x4 cs[4], sn[4]; bool ok[4], isq[4];
#pragma unroll
        for (int j = 0; j < 4; ++j) { const int itj = it + j * ngw; ok[j] = itj < M * 8; const int row = ok[j] ? itj >> 3 : 0, head = (itj & 7) * 4 + (lane >> 4); isq[j] = head < 24;
            p[j] = Z + (size_t)row * INW + C_Q + head * 128 + i4; const int pos = row & (SEQ - 1);
            a[j] = *(const u32x2*)p[j]; b[j] = *(const u32x2*)(p[j] + 64);
            cs[j] = *(const f32x4*)(rope + (size_t)pos * 64 + i4); sn[j] = *(const f32x4*)(rope + (size_t)SEQ * 64 + (size_t)pos * 64 + i4); }
#pragma unroll
        for (int j = 0; j < 4; ++j) {
            const float x1[4] = {bf_lo(a[j].x), bf_hi(a[j].x), bf_lo(a[j].y), bf_hi(a[j].y)}, x2[4] = {bf_lo(b[j].x), bf_hi(b[j].x), bf_lo(b[j].y), bf_hi(b[j].y)};
            float ss = (x1[0] * x1[0] + x1[1] * x1[1]) + (x1[2] * x1[2] + x1[3] * x1[3]) + (x2[0] * x2[0] + x2[1] * x2[1]) + (x2[2] * x2[2] + x2[3] * x2[3]);
            ss += __shfl_xor(ss, 1); ss += __shfl_xor(ss, 2); ss += __shfl_xor(ss, 4); ss += __shfl_xor(ss, 8);
            const float rstd = __builtin_amdgcn_rsqf(ss * (1.f / 128.f) + EPS);
            const f32x4 g1 = isq[j] ? gq1 : gk1, g2 = isq[j] ? gq2 : gk2;
            float o1[4], o2[4];
#pragma unroll
            for (int e = 0; e < 4; ++e) { const float y1 = x1[e] * rstd * g1[e], y2 = x2[e] * rstd * g2[e]; o1[e] = y1 * cs[j][e] - y2 * sn[j][e]; o2[e] = y2 * cs[j][e] + y1 * sn[j][e]; }
            u32x2 wa, wb; wa.x = pk2(o1[0], o1[1]); wa.y = pk2(o1[2], o1[3]); wb.x = pk2(o2[0], o2[1]); wb.y = pk2(o2[2], o2[3]);
            if (ok[j]) { *(u32x2*)p[j] = wa; *(u32x2*)(p[j] + 64) = wb; }
        }
    }
}
__device__ __forceinline__ void gmlp_unit(LAS unsigned char* lds, bf16_t* Z, const float* ln_g, const float* ln_b, const float* w_s, const float* b_s, int cidx, int g, int tid) {
    constexpr int LSTR = 272;
    LAS unsigned char* VT = lds; LAS unsigned char* WS = lds + 128 * LSTR;
    const int row0 = cidx * 128;
    u32x2 uu[8];
    { const int wv_ = tid >> 6, ln_ = tid & 63; const bf16_t* up_ = Z + (size_t)(row0 + wv_ * 16 + (ln_ & 15)) * INW + g * 128 + 4 * (ln_ >> 4);
#pragma unroll
      for (int ct = 0; ct < 8; ++ct) uu[ct] = *(const u32x2*)(up_ + 16 * ct); }
    f32x4 wreg[8];
    { const float* wp_ = w_s + ((size_t)g * 128 + (tid >> 2)) * 128 + (tid & 3) * 32;
#pragma unroll
      for (int q = 0; q < 8; ++q) wreg[q] = *(const f32x4*)(wp_ + 4 * q); }
    {
        const int j = tid >> 2, cq = (tid & 3) * 32;
        const bf16_t* vp = Z + (size_t)(row0 + j) * INW + 1024 + g * 128 + cq;
        u32x4 raw[4];
#pragma unroll
        for (int q = 0; q < 4; ++q) raw[q] = *(const u32x4*)(vp + 8 * q);
        float x[32];
#pragma unroll
        for (int q = 0; q < 4; ++q)
#pragma unroll
            for (int e = 0; e < 4; ++e) { x[8 * q + 2 * e] = bf_lo(raw[q][e]); x[8 * q + 2 * e + 1] = bf_hi(raw[q][e]); }
        float s = 0.f;
#pragma unroll
        for (int c = 0; c < 32; ++c) s += x[c];
        s += __shfl_xor(s, 1); s += __shfl_xor(s, 2);
        const float mean = s * (1.f / 128.f); float q2 = 0.f;
#pragma unroll
        for (int c = 0; c < 32; ++c) { x[c] -= mean; q2 += x[c] * x[c]; }
        q2 += __shfl_xor(q2, 1); q2 += __shfl_xor(q2, 2);
        const float rstd = __builtin_amdgcn_rsqf(q2 * (1.f / 128.f) + EPS);
        const float* gp = ln_g + g * 128 + cq; const float* bp = ln_b + g * 128 + cq;
#pragma unroll
        for (int c4 = 0; c4 < 8; ++c4) { const f32x4 gg = *(const f32x4*)(gp + 4 * c4), bb = *(const f32x4*)(bp + 4 * c4);
#pragma unroll
            for (int e = 0; e < 4; ++e) { const int c = 4 * c4 + e; const float y = x[c] * rstd * gg[e] + bb[e];
                *(LAS unsigned short*)(VT + (cq + c) * LSTR + j * 2) = (unsigned short)f2bf(y); } }
    }
    {
        const int i = tid >> 2, jq = (tid & 3) * 32;
#pragma unroll
        for (int q = 0; q < 4; ++q) { f32x4 a = wreg[2 * q], b = wreg[2 * q + 1];
            const int j0 = jq + 8 * q;
#pragma unroll
            for (int e = 0; e < 4; ++e) { if (j0 + e > i) a[e] = 0.f; if (j0 + 4 + e > i) b[e] = 0.f; }
            u32x4 w; w.x = pk2(a[0], a[1]); w.y = pk2(a[2], a[3]); w.z = pk2(b[0], b[1]); w.w = pk2(b[2], b[3]);
            *(LAS u32x4*)(WS + i * LSTR + j0 * 2) = w; }
    }
    __syncthreads();
    const int wv = tid >> 6, lane = tid & 63, fr = lane & 15, fq = lane >> 4;
    f32x4 acc[8];
#pragma unroll
    for (int ct = 0; ct < 8; ++ct) acc[ct] = (f32x4){0.f, 0.f, 0.f, 0.f};
#pragma unroll
    for (int ks = 0; ks < 4; ++ks) {
        const bf16x8 bw = *(const LAS bf16x8*)(WS + (wv * 16 + fr) * LSTR + (ks * 32 + fq * 8) * 2);
#pragma unroll
        for (int ct = 0; ct < 8; ++ct) { const bf16x8 av = *(const LAS bf16x8*)(VT + (ct * 16 + fr) * LSTR + (ks * 32 + fq * 8) * 2);
            acc[ct] = __builtin_amdgcn_mfma_f32_16x16x32_bf16(av, bw, acc[ct], 0, 0, 0); }
    }
    {
        const int i = wv * 16 + fr; const float bs = b_s[g * 128 + i];
        bf16_t* up = Z + (size_t)(row0 + i) * INW + g * 128 + 4 * fq;
#pragma unroll
        for (int ct = 0; ct < 8; ++ct) {
            u32x2 w; w.x = pk2(bf_lo(uu[ct].x) * (acc[ct][0] + bs), bf_hi(uu[ct].x) * (acc[ct][1] + bs)); w.y = pk2(bf_lo(uu[ct].y) * (acc[ct][2] + bs), bf_hi(uu[ct].y) * (acc[ct][3] + bs));
            *(u32x2*)(up + 16 * ct) = w; }
    }
    __syncthreads();
}
__device__ __forceinline__ void merge_rows(bf16_t* Z, const float* LSE, const float* ga, const float* gb, int gw, int ngw, int lane) {
    const int ch0 = lane * 16, head = lane >> 3;
    f32x4 gav[2][2], gbv[2][2];
#pragma unroll
    for (int h2 = 0; h2 < 2; ++h2) { gav[h2][0] = *(const f32x4*)(ga + ch0 + 8 * h2); gav[h2][1] = *(const f32x4*)(ga + ch0 + 8 * h2 + 4); gbv[h2][0] = *(const f32x4*)(gb + ch0 + 8 * h2); gbv[h2][1] = *(const f32x4*)(gb + ch0 + 8 * h2 + 4); }
    for (int m0 = gw; m0 < M; m0 += 2 * ngw) {
        u32x4 q0[2][2], q1[2][2], q2[2][2], aa[2][2]; float l0[2], l1[2], l2[2]; bool ok[2];
#pragma unroll
        for (int r = 0; r < 2; ++r) { const int m = m0 + r * ngw; ok[r] = m < M; const int mm = ok[r] ? m : m0; const bf16_t* zr = Z + (size_t)mm * INW;
            l0[r] = LSE[((size_t)0 * M + mm) * 8 + head]; l1[r] = LSE[((size_t)1 * M + mm) * 8 + head]; l2[r] = LSE[((size_t)2 * M + mm) * 8 + head];
#pragma unroll
            for (int h2 = 0; h2 < 2; ++h2) { q0[r][h2] = *(const u32x4*)(zr + C_Q + ch0 + 8 * h2); q1[r][h2] = *(const u32x4*)(zr + C_Q + 1024 + ch0 + 8 * h2); q2[r][h2] = *(const u32x4*)(zr + C_Q + 2048 + ch0 + 8 * h2); aa[r][h2] = *(const u32x4*)(zr + ch0 + 8 * h2); } }
#pragma unroll
        for (int r = 0; r < 2; ++r) {
            const float mx = fmaxf(l0[r], fmaxf(l1[r], l2[r]));
            float e0 = __builtin_amdgcn_exp2f((l0[r] - mx) * 1.4426950408889634f), e1 = __builtin_amdgcn_exp2f((l1[r] - mx) * 1.4426950408889634f), e2 = __builtin_amdgcn_exp2f((l2[r] - mx) * 1.4426950408889634f);
            const float inv = __builtin_amdgcn_rcpf(e0 + e1 + e2); e0 *= inv; e1 *= inv; e2 *= inv;
            float ob[16], oa[16];
#pragma unroll
            for (int h2 = 0; h2 < 2; ++h2)
#pragma unroll
                for (int e = 0; e < 4; ++e) {
                    ob[8 * h2 + 2 * e] = e0 * bf_lo(q0[r][h2][e]) + e1 * bf_lo(q1[r][h2][e]) + e2 * bf_lo(q2[r][h2][e]); ob[8 * h2 + 2 * e + 1] = e0 * bf_hi(q0[r][h2][e]) + e1 * bf_hi(q1[r][h2][e]) + e2 * bf_hi(q2[r][h2][e]);
                    oa[8 * h2 + 2 * e] = bf_lo(aa[r][h2][e]); oa[8 * h2 + 2 * e + 1] = bf_hi(aa[r][h2][e]); }
            float sb = 0.f, sa = 0.f;
#pragma unroll
            for (int c = 0; c < 16; ++c) { sb += ob[c] * ob[c]; sa += oa[c] * oa[c]; }
            sb = wave_sum(sb); sa = wave_sum(sa);
            const float rb = __builtin_amdgcn_rsqf(sb * (1.f / 1024.f) + EPS), ra = __builtin_amdgcn_rsqf(sa * (1.f / 1024.f) + EPS);
            bf16_t* mr = Z + (size_t)(m0 + r * ngw) * INW;
            if (ok[r]) {
#pragma unroll
                for (int h2 = 0; h2 < 2; ++h2) {
                    const f32x4 ga0 = gav[h2][0], ga1 = gav[h2][1], gb0 = gbv[h2][0], gb1 = gbv[h2][1];
                    u32x4 wa, wb; const float* A = oa + 8 * h2; const float* B = ob + 8 * h2;
                    wa.x = pk2(A[0] * ra * ga0[0], A[1] * ra * ga0[1]); wa.y = pk2(A[2] * ra * ga0[2], A[3] * ra * ga0[3]); wa.z = pk2(A[4] * ra * ga1[0], A[5] * ra * ga1[1]); wa.w = pk2(A[6] * ra * ga1[2], A[7] * ra * ga1[3]);
                    wb.x = pk2(B[0] * rb * gb0[0], B[1] * rb * gb0[1]); wb.y = pk2(B[2] * rb * gb0[2], B[3] * rb * gb0[3]); wb.z = pk2(B[4] * rb * gb1[0], B[5] * rb * gb1[1]); wb.w = pk2(B[6] * rb * gb1[2], B[7] * rb * gb1[3]);
                    *(u32x4*)(mr + ch0 + 8 * h2) = wa; *(u32x4*)(mr + 1024 + ch0 + 8 * h2) = wb;
                }
            }
        }
    }
}
typedef swa::BlockRef<__hip_bfloat16, __hip_bfloat16> ABlock;
__device__ __forceinline__ ABlock attn_ref(int id, bf16_t* Zb, float* LSE) {
    __hip_bfloat16* Z = (__hip_bfloat16*)Zb;
    const int bh = id / 48, w48 = id - bh * 48, g = w48 >> 4, w16 = w48 & 15, b = bh >> 3, h = bh & 7;
    const int r = 1 << (2 * g), nqb = 16 >> (2 * g), rho = w16 / nqb, qb = w16 - rho * nqb;
    const size_t tok0 = (size_t)b * SEQ + rho, tokq = tok0 + (size_t)r * 256 * qb;
    ABlock R;
    R.K = Z + tok0 * INW + C_K + h * 128; R.V = Z + tok0 * INW + C_V + h * 128;
    R.Q = Z + tokq * INW + C_Q + g * 1024 + h * 128; R.O = Z + tokq * INW + C_Q + g * 1024 + h * 128;
    R.L = LSE + ((size_t)g * M + tokq) * 8 + h; R.P0 = 256 * qb; R.pitch = r * INW; R.lpitch = r * 8;
    return R;
}

#define RLX_AGENT __ATOMIC_RELAXED, __HIP_MEMORY_SCOPE_AGENT
#define XB_TMO      128
#define XB_XCNT(j)  (256  + 64 * (j))
#define XB_XSUB(j)  (1280 + 64 * (j))
#define XB_XGEN(j)  (2304 + 64 * (j))
#define XB_TOP      3328
#define XB_TOPGEN   3392
#define XCD_BAR_WORDS 3456
#define XB_SPIN_CAP (1u << 18)

__device__ __forceinline__ unsigned xb_ld(unsigned* p)              { return __hip_atomic_load(p, __ATOMIC_RELAXED, __HIP_MEMORY_SCOPE_AGENT); }
__device__ __forceinline__ unsigned xb_add(unsigned* p, unsigned v) { return __hip_atomic_fetch_add(p, v, __ATOMIC_RELAXED, __HIP_MEMORY_SCOPE_AGENT); }
__device__ __forceinline__ unsigned xb_xcc_id() { return (unsigned)__builtin_amdgcn_s_getreg((3 << 11) | 20) & 0xFu; }
#define XB_SPIN(cond, bar) do { unsigned _sp = 0; while (cond) { __builtin_amdgcn_s_sleep(1); \
    if ((++_sp & 255u) == 0u) { if (xb_ld(&(bar)[XB_TMO])) break; if (_sp > XB_SPIN_CAP) { atomicAdd(&(bar)[XB_TMO], 1u); break; } } } } while (0)

struct XcdBarrier {
    unsigned* bar; unsigned x;
    volatile LAS unsigned* st;
};

__device__ __forceinline__ XcdBarrier xcd_barrier_post(unsigned* bar, volatile LAS unsigned* st) {
    XcdBarrier b; b.bar = bar; b.x = xb_xcc_id(); b.st = st;
    if (threadIdx.x == 0) (void)xb_add(&bar[XB_XCNT(b.x)], 1u);
    return b;
}
__device__ __forceinline__ void xcd_barrier_complete(unsigned* bar, unsigned x, unsigned& nloc, unsigned& nx) {
    const unsigned G = gridDim.x * gridDim.y * gridDim.z;
    unsigned sum, cnt, mine, sp = 0u;
    for (;;) {
        sum = 0u; cnt = 0u; mine = 0u;
#pragma unroll
        for (unsigned j = 0; j < 16; ++j) { const unsigned c = xb_ld(&bar[XB_XCNT(j)]); sum += c; cnt += (c > 0u) ? 1u : 0u; mine = (j == x) ? c : mine; }
        if (sum == G) break;
        __builtin_amdgcn_s_sleep(1);
        if ((++sp & 255u) == 0u) { if (xb_ld(&bar[XB_TMO])) break; if (sp > XB_SPIN_CAP) { atomicAdd(&bar[XB_TMO], 1u); break; } }
    }
    nloc = mine > 0u ? mine : 1u; nx = cnt > 0u ? cnt : 1u;
}

__device__ __forceinline__ void xcd_barrier(const XcdBarrier& b) {
    asm volatile("s_waitcnt vmcnt(0)" ::: "memory");
    __syncthreads();
    if (threadIdx.x == 0) {
        unsigned* bar = b.bar;
        __builtin_amdgcn_s_waitcnt(0);
        unsigned nloc = b.st[0], nx = b.st[1];
        if (nloc == 0u) { xcd_barrier_complete(bar, b.x, nloc, nx); b.st[0] = nloc; b.st[1] = nx; }
        const unsigned old = xb_add(&bar[XB_XSUB(b.x)], 1u);
        const unsigned gen = old / nloc;
        if (old + 1u == (gen + 1u) * nloc) {
            __builtin_amdgcn_fence(__ATOMIC_RELEASE, "agent");
            asm volatile("s_waitcnt vmcnt(0)" ::: "memory");
            const unsigned og = xb_add(&bar[XB_TOP], 1u);
            const unsigned tg = og / nx;
            if (og + 1u == (tg + 1u) * nx) xb_add(&bar[XB_TOPGEN], 1u);
            else XB_SPIN(xb_ld(&bar[XB_TOPGEN]) == tg, bar);
            __builtin_amdgcn_fence(__ATOMIC_ACQUIRE, "agent");
            xb_add(&bar[XB_XGEN(b.x)], 1u);
            asm volatile("s_waitcnt vmcnt(0)" ::: "memory");
        } else {
            XB_SPIN(xb_ld(&bar[XB_XGEN(b.x)]) == gen, bar);
            __builtin_amdgcn_fence(__ATOMIC_ACQUIRE, "agent");
            asm volatile("s_waitcnt vmcnt(0)" ::: "memory");
        }
    }
    __syncthreads();
}

constexpr int PH_PER_LAYER = 7, N_PHASES = 1 + DEPTH * PH_PER_LAYER;
typedef const __attribute__((address_space(4))) Args* KArgs;
#define KARGS(A) KArgs A = (KArgs)__builtin_amdgcn_kernarg_segment_ptr(); asm volatile("" : "+s"(A))
#define PH_COMMON() KARGS(A); const int tid = ltid(), lane = tid & 63, wave = __builtin_amdgcn_readfirstlane(tid >> 6); const int G = gridDim.x, gw = blockIdx.x * NWAVES + wave, ngw = G * NWAVES; \
    unsigned char* ws = A->ws; (void)lane; (void)gw; (void)ngw; (void)ws
__global__ void __launch_bounds__(NWAVES * 64, 2) fwd_kernel(Args args_) {
    extern __shared__ __attribute__((aligned(16))) unsigned char lds[];
    int ph, ph_hi; { KARGS(A0); ph = A0->ph_lo; ph_hi = A0->ph_hi; }
#if ONE_LAUNCH
    { LAS unsigned* misc = (LAS unsigned*)((LAS unsigned char*)lds + MISC_OFF); if (threadIdx.x < 32) misc[threadIdx.x] = 0u; __syncthreads();
      KARGS(A0); (void)xcd_barrier_post((unsigned*)(A0->ws + WS_CTL) + CW_BAR, (volatile LAS unsigned*)(misc + 8)); }
#endif
#pragma unroll 1
    for (; ph < ph_hi; ++ph) {
#if NPASS > 1
        const int pe = ph >= N_PHASES ? ph - N_PHASES : ph;
        if (ph == N_PHASES) { KARGS(Az); float* rz = (float*)(Az->ws + WS_RSQ) + M; for (int i = blockIdx.x * 512 + threadIdx.x; i < 3 * M; i += gridDim.x * 512) rz[i] = 0.f; }
#else
        const int pe = ph;
#endif
        const int l = pe == 0 ? 0 : (pe - 1) / PH_PER_LAYER, s = pe == 0 ? -1 : (pe - 1) % PH_PER_LAYER;
        switch ((NPASS > 1 && ph < N_PHASES && ((PROBE_SKIP >> (s + 1)) & 1)) ? 99 : s) {
        case -1: for (int rep_ = 0; rep_ <= PROBE_DUP_PROLOGUE; ++rep_) {
            PH_COMMON(); LAS unsigned char* lds3 = (LAS unsigned char*)lds;
            LAS float* scr = (LAS float*)(lds3 + wave * 16384);
            constexpr int I_IN = (DM / 64) * (INW / 32), I_OUT = (DM / 64) * (DM / 32), I_G = (DM / 64) * (DFF / 32), I_D = (DFF / 64) * (DM / 32), I_L = I_IN + I_OUT + 2 * I_G + I_D;
            for (int it = gw; it < DEPTH * I_L; it += ngw) {
                const int li = it / I_L; int r = it - li * I_L; unsigned char* wd = ws + WS_W + (size_t)li * W_LAYER;
                if (r < I_IN) { transpose_item(A->in[2] + (size_t)li * DM * INW, DM, INW, (bf16_t*)(wd + W_IN_OFF), 3, A->in[1] + (size_t)li * DM, scr, r, lane); continue; } r -= I_IN;
                if (r < I_OUT) { transpose_item(A->in[11] + (size_t)li * DM * DM, DM, DM, (bf16_t*)(wd + W_OUT_OFF), 0, nullptr, scr, r, lane); continue; } r -= I_OUT;
                if (r < I_G) { transpose_item(A->in[13] + (size_t)li * DM * DFF, DM, DFF, (bf16_t*)(wd + W_GU_OFF), 1, A->in[12] + (size_t)li * DM, scr, r, lane); continue; } r -= I_G;
                if (r < I_G) { transpose_item(A->in[14] + (size_t)li * DM * DFF, DM, DFF, (bf16_t*)(wd + W_GU_OFF), 2, A->in[12] + (size_t)li * DM, scr, r, lane); continue; } r -= I_G;
                transpose_item(A->in[15] + (size_t)li * DFF * DM, DFF, DM, (bf16_t*)(wd + W_DN_OFF), 0, nullptr, scr, r, lane);
            }
            float* rope = (float*)(ws + WS_ROPE);
            for (int e = blockIdx.x * (NWAVES * 64) + tid; e < SEQ * 64; e += G * NWAVES * 64) {
                const int pos = e >> 6, i = e & 63;
                const float inv_freq = __builtin_amdgcn_exp2f(-(float)(2 * i) * (1.0f / 128.0f) * 13.287712379549449f);
                const float ang = (float)pos * inv_freq;
                double rev = (double)ang * 0.15915494309189535; rev -= __builtin_rint(rev);
                ((unsigned*)rope)[e] = pk2(__builtin_amdgcn_cosf((float)rev), __builtin_amdgcn_sinf((float)rev));
            }
            convert_rows(A->in[0], (bf16_t*)(ws + WS_XN), (float*)(ws + WS_RSQ), gw, ngw, lane);
        } break;
#ifndef NO_G1
        case 0: {
            PH_COMMON();
            pg8::Gemm g{(const bf16_t*)(ws + WS_XN), (const bf16_t*)(ws + WS_W + (size_t)l * W_LAYER + W_IN_OFF), M, INW, DM, DM}; pg8::StaticOrder S; S.init(M, INW, G, (int)blockIdx.x);
            pg8::RowScale rsc{(const float*)(ws + WS_RSQ) + (size_t)(l == 0 ? 0 : 2) * 8 * M, l == 0 ? 1 : 8, M, (LAS float*)((LAS unsigned char*)lds + RT_OFF)};
            pg8::EpiZ E{(bf16_t*)(ws + WS_Z), INW, rsc, A->in[7] + (size_t)l * 128, A->in[8] + (size_t)l * 128, (const float*)(ws + WS_ROPE), (LAS float*)((LAS unsigned char*)lds + XL_OFF)};
            pg8::gemm_phase<pg8::EpiZ, pg8::StaticOrder, true, true>((LAS unsigned char*)lds, g, S, E);
        } break;
#endif
#ifndef NO_MIX
        case 1: {
            PH_COMMON(); bf16_t* Z = (bf16_t*)(ws + WS_Z);
            const float* lng = A->in[3] + (size_t)l * 1024; const float* lnb = A->in[4] + (size_t)l * 1024;
            const float* wsp = A->in[5] + (size_t)l * 8 * 128 * 128; const float* bsp = A->in[6] + (size_t)l * 1024;
            for (int u = blockIdx.x; u < (M / 128) * 8; u += G) gmlp_unit((LAS unsigned char*)lds, Z, lng, lnb, wsp, bsp, u >> 3, u & 7, tid);
        } break;
#endif
#ifndef NO_ATTN
        case 2: {
            KARGS(A); bf16_t* Z = (bf16_t*)(A->ws + WS_Z); float* LSE = (float*)(A->ws + WS_LSE); const int G = gridDim.x;
            constexpr int TOTAL = NBATCH * 8 * 48;
            const bool xl8 = (G == 256); const int vcu = (blockIdx.x & 7) * 32 + (blockIdx.x >> 3);
#define ATT_ID(i) (xl8 ? ((vcu >> 3) * 48 + ((i) >> 1) * 16 + 2 * (vcu & 7) + ((i) & 1)) : ((int)blockIdx.x + (i) * G))
#define ATT_MORE(i) (xl8 ? (i) < 6 : ((int)blockIdx.x + (i) * G) < TOTAL)
            int i = 0;
            if (ATT_MORE(0)) {
                ABlock cur = attn_ref(ATT_ID(0), Z, LSE);
                swa::Seam<__hip_bfloat16> S;
                swa::causal_swa_prime<__hip_bfloat16, __hip_bfloat16>(cur, 129, (char*)lds, S);
                for (;;) {
                    const bool last = !ATT_MORE(i + 1);
                    const ABlock nxt = last ? cur : attn_ref(ATT_ID(i + 1), Z, LSE);
                    swa::causal_swa_block<__hip_bfloat16, __hip_bfloat16>(cur, nxt, SEQ, 129, (char*)lds, S);
                    if (last) break;
                    cur = nxt; ++i;
                }
            }
#undef ATT_ID
#undef ATT_MORE
        } break;
#endif
#ifndef NO_MERGE
        case 3: { PH_COMMON(); merge_rows((bf16_t*)(ws + WS_Z), (const float*)(ws + WS_LSE), A->in[9] + (size_t)l * 1024, A->in[10] + (size_t)l * 1024, gw, ngw, lane); } break;
#endif
#ifndef NO_G5
        case 4: {
            PH_COMMON();
            pg8::Gemm g{(const bf16_t*)(ws + WS_Z), (const bf16_t*)(ws + WS_W + (size_t)l * W_LAYER + W_OUT_OFF), M, DM, DM, INW}; pg8::StaticOrder S; S.init(M, DM, G, (int)blockIdx.x);
            pg8::EpiRes E{(bf16_t*)(ws + WS_XN), nullptr, DM, (float*)(ws + WS_RSQ) + (size_t)(l == 0 ? 1 : 3) * 8 * M, M, (LAS float*)((LAS unsigned char*)lds + XL_OFF)};
            pg8::gemm_phase<pg8::EpiRes, pg8::StaticOrder, true, true>((LAS unsigned char*)lds, g, S, E);
        } break;
#endif
#ifndef NO_G7
        case 5: {
            PH_COMMON();
            pg8::Gemm g{(const bf16_t*)(ws + WS_XN), (const bf16_t*)(ws + WS_W + (size_t)l * W_LAYER + W_GU_OFF), M, 2 * DFF, DM, DM}; pg8::StaticOrder S; S.init(M, 2 * DFF, G, (int)blockIdx.x);
            pg8::RowScale rsc{(const float*)(ws + WS_RSQ) + (size_t)(l == 0 ? 1 : 3) * 8 * M, 8, M, (LAS float*)((LAS unsigned char*)lds + RT_OFF)};
            pg8::EpiSwiGLU E{(bf16_t*)(ws + WS_Z), DFF, rsc};
            pg8::gemm_phase<pg8::EpiSwiGLU, pg8::StaticOrder, true, true>((LAS unsigned char*)lds, g, S, E);
        } break;
#endif
#ifndef NO_G8
        case 6: {
            PH_COMMON();
            pg8::Gemm g{(const bf16_t*)(ws + WS_Z), (const bf16_t*)(ws + WS_W + (size_t)l * W_LAYER + W_DN_OFF), M, DM, DFF, DFF}; pg8::StaticOrder S; S.init(M, DM, G, (int)blockIdx.x);
            pg8::EpiRes E{(bf16_t*)(ws + WS_XN), l == 0 ? (float*)nullptr : A->out, DM, l == 0 ? (float*)(ws + WS_RSQ) + (size_t)2 * 8 * M : (float*)nullptr, M, (LAS float*)((LAS unsigned char*)lds + XL_OFF)};
            pg8::gemm_phase<pg8::EpiRes, pg8::StaticOrder, true, true>((LAS unsigned char*)lds, g, S, E);
        } break;
#endif
        default: break;
        }
#if ONE_LAUNCH
        if (ph + 1 < ph_hi && s != 1) {
            if (ph_hi < 0) cg::this_grid().sync();
            { KARGS(Ab); XcdBarrier b; b.bar = (unsigned*)(Ab->ws + WS_CTL) + CW_BAR; b.x = xb_xcc_id(); b.st = (volatile LAS unsigned*)((LAS unsigned char*)lds + MISC_OFF) + 8; xcd_barrier(b); }
        }
#endif
    }
}

extern "C" void kernel_launch(void* const* d_in, const int* in_sizes, int n_in, void* d_out, int out_size, void* d_ws, size_t ws_size, hipStream_t stream) {
    static int grid = 0;
    if (grid == 0) {
        if (n_in != 16 || out_size != M * DM || ws_size < WS_END) { fprintf(stderr, "kernel_launch: unexpected shapes (n_in %d out %d ws %zu)\n", n_in, out_size, ws_size); grid = -1; return; }
        int dev = 0, cus = 0, per_cu = 0;
        (void)hipGetDevice(&dev); (void)hipDeviceGetAttribute(&cus, hipDeviceAttributeMultiprocessorCount, dev);
        if (hipFuncSetAttribute((const void*)fwd_kernel, hipFuncAttributeMaxDynamicSharedMemorySize, LDS_BYTES) != hipSuccess) fprintf(stderr, "kernel_launch: hipFuncSetAttribute failed\n");
        if (hipOccupancyMaxActiveBlocksPerMultiprocessor(&per_cu, (const void*)fwd_kernel, NWAVES * 64, LDS_BYTES) != hipSuccess || per_cu < 1) per_cu = 1;
        (void)hipGetLastError();
        if (cus <= 0) cus = 256;
        if (cus * per_cu < 256) { fprintf(stderr, "kernel_launch: needs 256 co-resident workgroups (have %d x %d)\n", cus, per_cu); grid = -1; return; }
        grid = 256;
    }
    if (grid < 0) return;
    (void)hipMemsetAsync((char*)d_ws + WS_CTL, 0, CTL_ZERO_BYTES, stream);
    Args a{};
    for (int i = 0; i < 16; ++i) a.in[i] = (const float*)d_in[i];
    a.out = (float*)d_out; a.ws = (unsigned char*)d_ws;
#if ONE_LAUNCH
    a.ph_lo = 0; a.ph_hi = NPASS * N_PHASES;
    void* kargs[] = {&a};
    hipError_t e = hipLaunchCooperativeKernel((const void*)fwd_kernel, dim3(grid), dim3(NWAVES * 64), kargs, LDS_BYTES, stream);
    if (e != hipSuccess) fprintf(stderr, "kernel_launch: cooperative launch failed: %s (grid %d)\n", hipGetErrorString(e), grid);
#else
    for (int ph = 0; ph < N_PHASES; ++ph) { a.ph_lo = ph; a.ph_hi = ph + 1; hipLaunchKernelGGL(fwd_kernel, dim3(grid), dim3(NWAVES * 64), LDS_BYTES, stream, a); }
#endif
}
```

```cpp
#include <hip/hip_runtime.h>
#include <hip/hip_bf16.h>
#include <hip/hip_cooperative_groups.h>
#include <cstdio>
#include <cstdint>
namespace cg = cooperative_groups;
__device__ __forceinline__ int ltid() { int t = threadIdx.x; asm volatile("" : "+v"(t)); return t; }
namespace pg8 {
#define PG8_LAS __attribute__((address_space(3)))
typedef unsigned short bf16_t;
typedef short bf16x8 __attribute__((ext_vector_type(8)));
typedef float f32x4 __attribute__((ext_vector_type(4)));
typedef unsigned u32x4 __attribute__((ext_vector_type(4)));
constexpr int BM = 256, BK = 64, HALF = 128, HTB = HALF * BK * 2  , STAGE_BYTES = 8 * HTB, NXCD = 8, WGM = 8;

__host__ __device__ __forceinline__ int lds_byte(int r, int c) { const int st = (r >> 4) * 2 + (c >> 5), rr = r & 15, cc = c & 31, ob = rr * 64 + cc * 2; return st * 1024 + (ob ^ (((ob >> 9) & 1) << 5)); }
__host__ __device__ __forceinline__ void stage_rc(int b, int& R, int& C) { const int st = b / 1024, sb = b % 1024, swz = sb ^ (((sb >> 9) & 1) << 5); R = (st >> 1) * 16 + swz / 64; C = (st & 1) * 32 + (swz % 64) / 2; }
__host__ __device__ __forceinline__ int perm32(int rho) { const int n = rho >> 4, i = rho & 15; return 8 * (i >> 2) + 4 * n + (i & 3); }

struct Unit { int pm, pn; };
struct Gemm { const bf16_t* A; const bf16_t* Bt; int M, N, K, lda; };

struct StaticOrder {
    int nM, nN, nwg, G, c;
    __host__ __device__ void init(int M, int N, int G_, int c_) { nM = M / BM; nN = N / BM; nwg = nM * nN; G = G_; c = c_; }
    __host__ __device__ bool next(int i, Unit& u) const {
        const long L = (long)i * G + c; if (L >= nwg) return false;
        int wgid = (int)L; { const int q = nwg / NXCD, r = nwg % NXCD, xcd = wgid % NXCD, off = wgid / NXCD; wgid = (xcd < r ? xcd * (q + 1) : r * (q + 1) + (xcd - r) * q) + off; }
        const int nig = WGM * nN, gid = wgid / nig, fm = gid * WGM, gsz = (nM - fm) < WGM ? (nM - fm) : WGM;
        u.pm = fm + ((wgid % nig) % gsz); u.pn = (wgid % nig) / gsz; return true;
    }
    __device__ __forceinline__ void a_ready(const Unit&) const {}
    __device__ __forceinline__ void done(const Unit&) const {}
};

__device__ __forceinline__ unsigned cvt_pk_bf16(float lo, float hi) { unsigned r; asm volatile("v_cvt_pk_bf16_f32 %0, %1, %2" : "=v"(r) : "v"(lo), "v"(hi)); return r; }
typedef float f32x2 __attribute__((ext_vector_type(2)));
__device__ __forceinline__ f32x2 gelu_pk(f32x2 v) {
    const f32x2 av = __builtin_elementwise_abs(v), d = av * 0.2316418882f + 1.0f;
    f32x2 t; t.x = __builtin_amdgcn_rcpf(d.x); t.y = __builtin_amdgcn_rcpf(d.y);
    f32x2 q = t * 0.5307027145f + (-0.7265760135f); q = q * t + 0.7107068705f; q = q * t + (-0.142248368f); q = q * t + 0.127414796f; q = q * t;
    const f32x2 s = (v * v) * (-0.72134752044f);
    f32x2 e; e.x = __builtin_amdgcn_exp2f(s.x); e.y = __builtin_amdgcn_exp2f(s.y);
    const f32x2 m = v * (q * e), r = v - m;
    f32x2 o; o.x = v.x < 0.f ? m.x : r.x; o.y = v.y < 0.f ? m.y : r.y; return o;
}
typedef unsigned u32x2 __attribute__((ext_vector_type(2)));
struct RowScale {
    const float* rsq; int nparts; int mtot; PG8_LAS float* tab;
    __device__ __forceinline__ int begin(const Unit& u) const {
        const int t = ltid();
        if (t < BM) { float v[8];
#pragma unroll
            for (int p = 0; p < 8; ++p) v[p] = rsq[(size_t)(p < nparts ? p : 0) * mtot + u.pm * BM + t];
            float s = v[0];
#pragma unroll
            for (int p = 1; p < 8; ++p) s += (p < nparts) ? v[p] : 0.f;
            tab[t] = s; }
        asm volatile("s_waitcnt lgkmcnt(0)\n\ts_barrier" ::: "memory");
        return u.pm;
    }
    __device__ __forceinline__ void preload(const Unit&, int, int wr, int fr, float (&pre)[8]) const {
#pragma unroll
        for (int i = 0; i < 8; ++i) pre[i] = tab[wr * 64 + fr + (i >> 2) * HALF + (i & 3) * 16];
    }
};
__device__ __forceinline__ float silu_f(float x) { return x * __builtin_amdgcn_rcpf(1.0f + __builtin_amdgcn_exp2f(-1.4426950408889634f * x)); }
struct EpiZ {
    static constexpr bool PERM = true, AFTER_DRAIN = false;
    bf16_t* O; int ldc; RowScale rsc; const float* qg; const float* kg; const float* rope; PG8_LAS float* xl;
    __device__ __forceinline__ int begin(const Unit& u) const { return rsc.begin(u); }
    __device__ __forceinline__ void preload(const Unit& u, int tab_pm, int wr, int fr, float (&pre)[8]) const { rsc.preload(u, tab_pm, wr, fr, pre); }
    __device__ __forceinline__ void operator()(const f32x4 (&acc)[2][2][4][2], const Unit& u, int wr, int wc, int fr, int fq, const float (&pre)[8]) const {
        const int row0 = u.pm * BM + wr * 64 + fr; const int col0 = u.pn * BM + wc * 32 + 8 * fq;
        if (u.pn >= 8 && u.pn < 24) {
            float rsv[2][4];
            u32x4 csv[2][4];
#pragma unroll
            for (int ai = 0; ai < 2; ++ai)
#pragma unroll
                for (int m = 0; m < 4; ++m) csv[ai][m] = *(const u32x4*)((const unsigned*)rope + (size_t)((row0 + ai * HALF + m * 16) & 4095) * 64 + 16 * wc + 4 * fq);
            asm volatile("" ::: "memory");
#pragma unroll
            for (int ai = 0; ai < 2; ++ai)
#pragma unroll
                for (int m = 0; m < 4; ++m) { const float rs = __builtin_amdgcn_rsqf(pre[ai * 4 + m] * (1.f / 2048.f) + 1e-6f); rsv[ai][m] = rs;
#pragma unroll
                    for (int bj = 0; bj < 2; ++bj) { const f32x4 a = acc[ai][bj][m][0] * rs, b = acc[ai][bj][m][1] * rs;
                        float ss = ((a[0] * a[0] + a[1] * a[1]) + (a[2] * a[2] + a[3] * a[3])) + ((b[0] * b[0] + b[1] * b[1]) + (b[2] * b[2] + b[3] * b[3]));
                        ss += __shfl_xor(ss, 16); ss += __shfl_xor(ss, 32);
                        if (fq == 0) xl[((ai * HALF + wr * 64 + m * 16 + fr) * 2 + bj) * 4 + wc] = ss; } }
            const float* gn = (u.pn < 20 ? qg : kg) + 16 * wc + 4 * fq;
            const f32x4 g1 = *(const f32x4*)gn, g2 = *(const f32x4*)(gn + 64);
            asm volatile("s_waitcnt lgkmcnt(0)\n\ts_barrier" ::: "memory");
#pragma unroll
            for (int ai = 0; ai < 2; ++ai)
#pragma unroll
                for (int m = 0; m < 4; ++m) { const int row = row0 + ai * HALF + m * 16; bf16_t* rowp = O + (size_t)row * ldc + col0; const float rs = rsv[ai][m];
                    const u32x4 cw = csv[ai][m]; const f32x4 cs = {__builtin_bit_cast(float, cw.x << 16), __builtin_bit_cast(float, cw.y << 16), __builtin_bit_cast(float, cw.z << 16), __builtin_bit_cast(float, cw.w << 16)},
                        sn = {__builtin_bit_cast(float, cw.x & 0xffff0000u), __builtin_bit_cast(float, cw.y & 0xffff0000u), __builtin_bit_cast(float, cw.z & 0xffff0000u), __builtin_bit_cast(float, cw.w & 0xffff0000u)};
#pragma unroll
                    for (int bj = 0; bj < 2; ++bj) { const f32x4 p = *(const PG8_LAS f32x4*)(xl + ((ai * HALF + wr * 64 + m * 16 + fr) * 2 + bj) * 4);
                        const float rh = rs * __builtin_amdgcn_rsqf(((p[0] + p[1]) + (p[2] + p[3])) * (1.f / 128.f) + 1e-6f);
                        const f32x4 y1 = acc[ai][bj][m][0] * rh * g1, y2 = acc[ai][bj][m][1] * rh * g2;
                        const f32x4 o1 = y1 * cs - y2 * sn, o2 = y2 * cs + y1 * sn;
                        u32x4 w; w.x = cvt_pk_bf16(o1[0], o1[1]); w.y = cvt_pk_bf16(o1[2], o1[3]); w.z = cvt_pk_bf16(o2[0], o2[1]); w.w = cvt_pk_bf16(o2[2], o2[3]);
                        *(u32x4*)(rowp + bj * HALF) = w; } }
            return;
        }
        const bool act = u.pn < 8;
#pragma unroll
        for (int ai = 0; ai < 2; ++ai)
#pragma unroll
            for (int m = 0; m < 4; ++m) { bf16_t* rowp = O + (size_t)(row0 + ai * HALF + m * 16) * ldc + col0;
                const float rs = __builtin_amdgcn_rsqf(pre[ai * 4 + m] * (1.f / 2048.f) + 1e-6f);
#pragma unroll
                for (int bj = 0; bj < 2; ++bj) { f32x4 v0 = acc[ai][bj][m][0] * rs, v1 = acc[ai][bj][m][1] * rs;
                    if (act) { f32x2 a = gelu_pk((f32x2){v0[0], v0[1]}), b = gelu_pk((f32x2){v0[2], v0[3]}), c = gelu_pk((f32x2){v1[0], v1[1]}), d = gelu_pk((f32x2){v1[2], v1[3]});
                        v0 = (f32x4){a.x, a.y, b.x, b.y}; v1 = (f32x4){c.x, c.y, d.x, d.y}; }
                    u32x4 w; w.x = cvt_pk_bf16(v0[0], v0[1]); w.y = cvt_pk_bf16(v0[2], v0[3]); w.z = cvt_pk_bf16(v1[0], v1[1]); w.w = cvt_pk_bf16(v1[2], v1[3]);
                    *(u32x4*)(rowp + bj * HALF) = w; } }
    }
};
struct EpiRes {
    static constexpr bool PERM = true, AFTER_DRAIN = false;
    bf16_t* xb; float* outf; int ldc; float* rsq_out; int mtot; PG8_LAS float* xl;
    __device__ __forceinline__ int begin(const Unit& u) const { return u.pm; }
    __device__ __forceinline__ void preload(const Unit&, int, int, int, float (&pre)[8]) const {
#pragma unroll
        for (int i = 0; i < 8; ++i) pre[i] = 0.f;
    }
    __device__ __forceinline__ void operator()(const f32x4 (&acc)[2][2][4][2], const Unit& u, int wr, int wc, int fr, int fq, const float (&)[8]) const {
        const int col0 = u.pn * BM + wc * 32 + 8 * fq;
        u32x4 bx[2][4][2];
#pragma unroll
        for (int ai = 0; ai < 2; ++ai)
#pragma unroll
            for (int m = 0; m < 4; ++m)
#pragma unroll
                for (int bj = 0; bj < 2; ++bj) bx[ai][m][bj] = *(const u32x4*)(xb + (size_t)(u.pm * BM + ai * HALF + wr * 64 + m * 16 + fr) * ldc + col0 + bj * HALF);
        asm volatile("" ::: "memory");
#pragma unroll
        for (int ai = 0; ai < 2; ++ai)
#pragma unroll
            for (int m = 0; m < 4; ++m) { const int rl = ai * HALF + wr * 64 + m * 16 + fr; const size_t off = (size_t)(u.pm * BM + rl) * ldc + col0;
                float ss = 0.f;
#pragma unroll
                for (int bj = 0; bj < 2; ++bj) { const u32x4 b = bx[ai][m][bj];
                    f32x4 o0, o1;
                    o0[0] = __builtin_bit_cast(float, b.x << 16) + acc[ai][bj][m][0][0]; o0[1] = __builtin_bit_cast(float, b.x & 0xffff0000u) + acc[ai][bj][m][0][1];
                    o0[2] = __builtin_bit_cast(float, b.y << 16) + acc[ai][bj][m][0][2]; o0[3] = __builtin_bit_cast(float, b.y & 0xffff0000u) + acc[ai][bj][m][0][3];
                    o1[0] = __builtin_bit_cast(float, b.z << 16) + acc[ai][bj][m][1][0]; o1[1] = __builtin_bit_cast(float, b.z & 0xffff0000u) + acc[ai][bj][m][1][1];
                    o1[2] = __builtin_bit_cast(float, b.w << 16) + acc[ai][bj][m][1][2]; o1[3] = __builtin_bit_cast(float, b.w & 0xffff0000u) + acc[ai][bj][m][1][3];
                    if (outf) { *(f32x4*)(outf + off + bj * HALF) = o0; *(f32x4*)(outf + off + bj * HALF + 4) = o1; }
                    else { ss += ((o0[0] * o0[0] + o0[1] * o0[1]) + (o0[2] * o0[2] + o0[3] * o0[3])) + ((o1[0] * o1[0] + o1[1] * o1[1]) + (o1[2] * o1[2] + o1[3] * o1[3]));
                        u32x4 w; w.x = cvt_pk_bf16(o0[0], o0[1]); w.y = cvt_pk_bf16(o0[2], o0[3]); w.z = cvt_pk_bf16(o1[0], o1[1]); w.w = cvt_pk_bf16(o1[2], o1[3]); *(u32x4*)(xb + off + bj * HALF) = w; } }
                if (rsq_out) { ss += __shfl_xor(ss, 16); ss += __shfl_xor(ss, 32); if (fq == 0) xl[rl * 4 + wc] = ss; } }
        if (rsq_out) {
            asm volatile("s_waitcnt lgkmcnt(0)\n\ts_barrier" ::: "memory");
            const int t = ltid();
            if (t < BM) { const f32x4 p = *(const PG8_LAS f32x4*)(xl + 4 * t); rsq_out[(size_t)u.pn * mtot + u.pm * BM + t] = (p[0] + p[1]) + (p[2] + p[3]); }
        }
    }
};
struct EpiSwiGLU {
    static constexpr bool PERM = true, AFTER_DRAIN = false;
    bf16_t* O; int ldc; RowScale rsc;
    __device__ __forceinline__ int begin(const Unit& u) const { return rsc.begin(u); }
    __device__ __forceinline__ void preload(const Unit& u, int tab_pm, int wr, int fr, float (&pre)[8]) const { rsc.preload(u, tab_pm, wr, fr, pre); }
    __device__ __forceinline__ void operator()(const f32x4 (&acc)[2][2][4][2], const Unit& u, int wr, int wc, int fr, int fq, const float (&pre)[8]) const {
        const int row0 = u.pm * BM + wr * 64 + fr; const int col0 = u.pn * HALF + wc * 32 + 8 * fq;
#pragma unroll
        for (int ai = 0; ai < 2; ++ai)
#pragma unroll
            for (int m = 0; m < 4; ++m) { bf16_t* rowp = O + (size_t)(row0 + ai * HALF + m * 16) * ldc + col0;
                const float rs = __builtin_amdgcn_rsqf(pre[ai * 4 + m] * (1.f / 2048.f) + 1e-6f);
                const f32x4 g0 = acc[ai][0][m][0] * rs, g1 = acc[ai][0][m][1] * rs, u0 = acc[ai][1][m][0] * rs, u1 = acc[ai][1][m][1] * rs;
                u32x4 w; w.x = cvt_pk_bf16(silu_f(g0[0]) * u0[0], silu_f(g0[1]) * u0[1]); w.y = cvt_pk_bf16(silu_f(g0[2]) * u0[2], silu_f(g0[3]) * u0[3]);
                w.z = cvt_pk_bf16(silu_f(g1[0]) * u1[0], silu_f(g1[1]) * u1[1]); w.w = cvt_pk_bf16(silu_f(g1[2]) * u1[2], silu_f(g1[3]) * u1[3]);
                *(u32x4*)rowp = w; }
    }
};
template <class Epi, class Sched, bool ALIGN_EPI = false, bool SP2 = false>
__device__ __forceinline__ void gemm_phase(PG8_LAS unsigned char* lds, const Gemm g, const Sched& S, const Epi& E) {
    const int tid = ltid(), wid = __builtin_amdgcn_readfirstlane(tid >> 6), lane = tid & 63, wr = wid >> 2, wc = wid & 3, fr = lane & 15, fq = lane >> 4;
    const int K = g.K, nt = K / BK;
    unsigned voffA[2], voffB[2];
#pragma unroll
    for (int i = 0; i < 2; ++i) { int R, C; stage_rc(tid * 16 + i * 8192, R, C); const int Rb = Epi::PERM ? ((R & ~31) + perm32(R & 31)) : R;
        voffA[i] = (unsigned)(R * g.lda + C) * 2u; voffB[i] = (unsigned)(Rb * K + C) * 2u; }
    const size_t kstep = (size_t)(BK * 2);
    const size_t hstep = (size_t)HALF * K * 2;
    const size_t tstep = 2 * hstep;
    const size_t hstepA = (size_t)HALF * g.lda * 2, tstepA = 2 * hstepA;
    const unsigned ldsw = (unsigned)wid * 1024u;
    const int aoff = lds_byte(wr * 64 + fr, fq * 8), boff = lds_byte(wc * 32 + fr, fq * 8);
#define PG8_SA(b, h) (((b) * 2 + (h)) * HTB)
#define PG8_SB(b, h) ((4 + (b) * 2 + (h)) * HTB)
#define PG8_STAGE(bufoff, gbase, voff) do { _Pragma("unroll") for (int _i = 0; _i < 2; ++_i) \
        __builtin_amdgcn_global_load_lds((const unsigned*)((const char*)(gbase) + (voff)[_i]), (PG8_LAS unsigned*)(lds + (bufoff) + ldsw + _i * 8192), 16, 0, 0); } while (0)
#define PG8_LDA(dst, b, h) do { _Pragma("unroll") for (int m = 0; m < 4; ++m) _Pragma("unroll") for (int k = 0; k < 2; ++k) dst[m][k] = *(const PG8_LAS bf16x8*)(lds + PG8_SA(b, h) + aoff + m * 2048 + k * 1024); } while (0)
#define PG8_LDB(dst, b, h) do { _Pragma("unroll") for (int n = 0; n < 2; ++n) _Pragma("unroll") for (int k = 0; k < 2; ++k) dst[n][k] = *(const PG8_LAS bf16x8*)(lds + PG8_SB(b, h) + boff + n * 2048 + k * 1024); } while (0)
#define PG8_MMA(ai, bj, At, Bt) do { __builtin_amdgcn_s_setprio(1); _Pragma("unroll") for (int m = 0; m < 4; ++m) _Pragma("unroll") for (int n = 0; n < 2; ++n) _Pragma("unroll") for (int k = 0; k < 2; ++k) \
        acc[ai][bj][m][n] = __builtin_amdgcn_mfma_f32_16x16x32_bf16(Bt[n][k], At[m][k], acc[ai][bj][m][n], 0, 0, 0); __builtin_amdgcn_s_setprio(0); } while (0)
#define PG8_WAIT_V(n) asm volatile("s_waitcnt vmcnt(" #n ")" ::: "memory")
#define PG8_WAIT_L(n) asm volatile("s_waitcnt lgkmcnt(" #n ")" ::: "memory")
#define PG8_BAR __builtin_amdgcn_s_barrier()
#define PG8_SCHED __builtin_amdgcn_sched_barrier(0)
    Unit cur, nxt; int ui = 0;
    if (!S.next(0, cur)) return;
    float pre[8], preN[8];
    const int tab_pm = E.begin(cur);
    E.preload(cur, tab_pm, wr, fr, pre);
    f32x4 acc[2][2][4][2];
#pragma unroll
    for (int a = 0; a < 2; ++a)
#pragma unroll
        for (int b = 0; b < 2; ++b)
#pragma unroll
            for (int m = 0; m < 4; ++m)
#pragma unroll
                for (int n = 0; n < 2; ++n) acc[a][b][m][n] = (f32x4){0.f, 0.f, 0.f, 0.f};
    bf16x8 At[4][2], B0[2][2], B1[2][2];
    const char* cA = (const char*)g.A + (size_t)cur.pm * tstepA; const char* cB = (const char*)g.Bt + (size_t)cur.pn * tstep;
    S.a_ready(cur);
    if constexpr (SP2) {
        PG8_STAGE(PG8_SB(0, 0), cB, voffB); PG8_STAGE(PG8_SB(0, 1), cB + hstep, voffB); PG8_STAGE(PG8_SA(0, 0), cA, voffA); PG8_STAGE(PG8_SA(0, 1), cA + hstepA, voffA);
        if (wr == 1) PG8_BAR;
        PG8_WAIT_V(2); PG8_BAR;
        PG8_STAGE(PG8_SB(1, 0), cB + kstep, voffB); PG8_STAGE(PG8_SA(1, 0), cA + kstep, voffA); PG8_STAGE(PG8_SB(1, 1), cB + hstep + kstep, voffB);
        PG8_WAIT_V(6); PG8_BAR;
    } else {
        PG8_STAGE(PG8_SB(0, 0), cB, voffB); PG8_STAGE(PG8_SA(0, 0), cA, voffA); PG8_STAGE(PG8_SB(0, 1), cB + hstep, voffB); PG8_STAGE(PG8_SA(0, 1), cA + hstepA, voffA);
        if (wr == 1) PG8_BAR;
        PG8_WAIT_V(4); PG8_BAR;
        PG8_STAGE(PG8_SB(1, 0), cB + kstep, voffB); PG8_STAGE(PG8_SA(1, 0), cA + kstep, voffA); PG8_STAGE(PG8_SB(1, 1), cB + hstep + kstep, voffB);
        PG8_WAIT_V(6); PG8_BAR;
    }
    for (;;) {
        const bool has_next = S.next(ui + 1, nxt);
        const char* nA = has_next ? (const char*)g.A + (size_t)nxt.pm * tstepA : cA; const char* nB = has_next ? (const char*)g.Bt + (size_t)nxt.pn * tstep : cB;
        for (int t = 0; t < nt; t += 2) {
            const bool last = (t == nt - 2);
            const char* a1 = cA + (size_t)(t + 1) * kstep;
            const char* a2 = last ? nA : cA + (size_t)(t + 2) * kstep; const char* b2 = last ? nB : cB + (size_t)(t + 2) * kstep;
            const char* a3 = a2 + kstep; const char* b3 = b2 + kstep;
            if (last && has_next) S.a_ready(nxt);
            if constexpr (SP2) {
            PG8_LDB(B0, 0, 0); PG8_LDB(B1, 0, 1); PG8_SCHED; PG8_LDA(At, 0, 0); PG8_STAGE(PG8_SA(1, 1), a1 + hstepA, voffA);
            PG8_WAIT_V(8); PG8_WAIT_L(0); PG8_BAR; PG8_MMA(0, 0, At, B0); PG8_MMA(0, 1, At, B1); PG8_BAR; PG8_SCHED;
            PG8_LDA(At, 0, 1); PG8_STAGE(PG8_SB(0, 0), b2, voffB); PG8_STAGE(PG8_SB(0, 1), b2 + hstep, voffB); PG8_STAGE(PG8_SA(0, 0), a2, voffA);
            PG8_WAIT_V(8); PG8_WAIT_L(0); PG8_BAR; PG8_MMA(1, 0, At, B0); PG8_MMA(1, 1, At, B1); PG8_BAR; PG8_SCHED;
            PG8_LDB(B0, 1, 0); PG8_LDB(B1, 1, 1); PG8_SCHED; PG8_LDA(At, 1, 0); PG8_STAGE(PG8_SA(0, 1), a2 + hstepA, voffA);
            PG8_WAIT_V(8); PG8_WAIT_L(0); PG8_BAR; PG8_MMA(0, 0, At, B0); PG8_MMA(0, 1, At, B1); PG8_BAR; PG8_SCHED;
            PG8_LDA(At, 1, 1); PG8_STAGE(PG8_SB(1, 0), b3, voffB); PG8_STAGE(PG8_SB(1, 1), b3 + hstep, voffB); PG8_STAGE(PG8_SA(1, 0), a3, voffA);
            PG8_WAIT_V(8); PG8_WAIT_L(0); PG8_BAR; PG8_MMA(1, 0, At, B0); PG8_MMA(1, 1, At, B1); PG8_BAR; PG8_SCHED;
            } else {
            PG8_LDB(B0, 0, 0); PG8_SCHED; PG8_LDA(At, 0, 0); PG8_STAGE(PG8_SA(1, 1), a1 + hstepA, voffA);
            PG8_WAIT_L(8); PG8_BAR; PG8_WAIT_L(0); PG8_MMA(0, 0, At, B0); PG8_BAR; PG8_SCHED;
            PG8_LDB(B1, 0, 1); PG8_STAGE(PG8_SB(0, 0), b2, voffB);
            PG8_BAR; PG8_WAIT_L(0); PG8_MMA(0, 1, At, B1); PG8_BAR;
            PG8_LDA(At, 0, 1); PG8_STAGE(PG8_SA(0, 0), a2, voffA);
            PG8_BAR; PG8_WAIT_L(0); PG8_MMA(1, 0, At, B0); PG8_BAR; PG8_SCHED;
            PG8_STAGE(PG8_SB(0, 1), b2 + hstep, voffB);
            PG8_WAIT_V(6); PG8_BAR; PG8_MMA(1, 1, At, B1); PG8_BAR;
            PG8_LDB(B0, 1, 0); PG8_SCHED; PG8_LDA(At, 1, 0); PG8_STAGE(PG8_SA(0, 1), a2 + hstepA, voffA);
            PG8_WAIT_L(8); PG8_BAR; PG8_WAIT_L(0); PG8_MMA(0, 0, At, B0); PG8_BAR; PG8_SCHED;
            PG8_LDB(B1, 1, 1); PG8_STAGE(PG8_SB(1, 0), b3, voffB);
            PG8_BAR; PG8_WAIT_L(0); PG8_MMA(0, 1, At, B1); PG8_BAR;
            PG8_LDA(At, 1, 1); PG8_STAGE(PG8_SA(1, 0), a3, voffA);
            PG8_BAR; PG8_WAIT_L(0); PG8_MMA(1, 0, At, B0); PG8_BAR; PG8_SCHED;
            PG8_STAGE(PG8_SB(1, 1), b3 + hstep, voffB);
            PG8_WAIT_V(6); PG8_BAR; PG8_MMA(1, 1, At, B1); PG8_BAR;
            }
        }
        if constexpr (ALIGN_EPI) { if (wr == 0) PG8_BAR; }
        if (has_next) E.preload(nxt, tab_pm, wr, fr, preN);
        if constexpr (!Epi::AFTER_DRAIN) { E(acc, cur, wr, wc, fr, fq, pre); S.done(cur); }
#pragma unroll
        for (int i_ = 0; i_ < 8; ++i_) pre[i_] = preN[i_];
        if (!has_next) break;
#pragma unroll
        for (int a = 0; a < 2; ++a)
#pragma unroll
            for (int b = 0; b < 2; ++b)
#pragma unroll
                for (int m = 0; m < 4; ++m)
#pragma unroll
                    for (int n = 0; n < 2; ++n) acc[a][b][m][n] = (f32x4){0.f, 0.f, 0.f, 0.f};
        cur = nxt; cA = nA; cB = nB; ++ui;
        if constexpr (ALIGN_EPI) { if (wr == 1) PG8_BAR; }
    }
    PG8_WAIT_V(0);
    if constexpr (!ALIGN_EPI) { if (wr == 0) PG8_BAR; }
    PG8_BAR;
    if constexpr (Epi::AFTER_DRAIN) { E.fused(acc, cur, wr, wc, fr, fq, lds, wid, lane); S.done(cur); }
#undef PG8_SA
#undef PG8_SB
#undef PG8_STAGE
#undef PG8_LDA
#undef PG8_LDB
#undef PG8_MMA
#undef PG8_WAIT_V
#undef PG8_WAIT_L
#undef PG8_BAR
#undef PG8_SCHED
}
}
namespace swa {
constexpr int D = 128;
constexpr float THR = 8.f;
constexpr bool WSKIP = true;
constexpr float SCALE = 0.08838834764831845f;
constexpr int NW = 8, QBLK = 32, KVBLK = 64, QB = NW * QBLK;
constexpr int SHM_V = KVBLK * D * 2, SHM_K = KVBLK * D * 2;
constexpr int LDS_BYTES = 2 * SHM_V + 2 * SHM_K + NW * 64 * 4;
using bf16 = __hip_bfloat16;
typedef short bf16x8 __attribute__((ext_vector_type(8)));
typedef short s16x4 __attribute__((ext_vector_type(4)));
typedef float f32x16 __attribute__((ext_vector_type(16)));
typedef float f32x4 __attribute__((ext_vector_type(4)));
typedef unsigned u32x4 __attribute__((ext_vector_type(4)));
template <class A, class Bt> struct same_t { static constexpr bool v = false; };
template <class A> struct same_t<A, A> { static constexpr bool v = true; };

#define KSWZ(row, colB) ((row) * 256 + ((colB) ^ (((row) & 7) << 4)))
#define SBAR() __builtin_amdgcn_sched_barrier(0)
__device__ __forceinline__ int v_st(int k, int c) { const int kk = (k & ~0xC) | ((k & 4) << 1) | ((k & 8) >> 1); return ((kk >> 3) * 4 + (c >> 5)) * 512 + ((kk & 7) * 32 + (c & 31)) * 2; }
__device__ __forceinline__ int v_rd_base(int lane) { return ((lane & 3) << 3) | (((lane >> 2) & 3) << 6) | (((lane >> 4) & 1) << 5) | (((lane >> 5) & 1) << 8); }
constexpr int v_rd_off(int d0, int ks, int half) { return d0 * 512 + ks * 4096 + half * 2048; }
__device__ __forceinline__ int crow(int r, int hi) { return (r & 3) + 8 * (r >> 2) + 4 * hi; }
__device__ __forceinline__ unsigned cvtpk(float lo, float hi) {
    unsigned r; asm volatile("v_cvt_pk_bf16_f32 %0, %1, %2" : "=v"(r) : "v"(lo), "v"(hi)); return r;
}
__device__ __forceinline__ bf16x8 pack8(f32x4 a, f32x4 b) {
    u32x4 w = {cvtpk(a[0], a[1]), cvtpk(a[2], a[3]), cvtpk(b[0], b[1]), cvtpk(b[2], b[3])};
    return *reinterpret_cast<bf16x8*>(&w);
}
template <class T> __device__ __forceinline__ bf16x8 load8(const T* p) {
    if constexpr (same_t<T, float>::v) { return pack8(*(const f32x4*)p, *(const f32x4*)(p + 4)); }
    else { return *reinterpret_cast<const bf16x8*>(p); }
}
__device__ __forceinline__ void mask_tile(f32x16& p0, f32x16& p1, int dq, unsigned W) {
    const float NEG = -__builtin_inff();
#pragma unroll
    for (int r = 0; r < 16; ++r) {
        const int c = (r & 3) + 8 * (r >> 2);
        if ((unsigned)(dq - c) >= W) p0[r] = NEG;
        if ((unsigned)(dq - c - 32) >= W) p1[r] = NEG;
    }
}
__device__ __forceinline__ void partialSM(f32x16& p0, f32x16& p1, float& m_reg, float& mn, float& alpha) {
    float pmax = p0[0]; for (int r = 1; r < 16; ++r) pmax = fmaxf(pmax, p0[r]); for (int r = 0; r < 16; ++r) pmax = fmaxf(pmax, p1[r]);
    { auto rr = __builtin_amdgcn_permlane32_swap(__float_as_uint(pmax), __float_as_uint(pmax), false, false);
      pmax = fmaxf(__uint_as_float(rr[0]), __uint_as_float(rr[1])); }
    constexpr float C2 = 1.4426950408889634f * SCALE;
    if (__builtin_expect(__all((pmax - m_reg) * SCALE <= THR), 1)) { mn = m_reg; alpha = 1.f; }
    else { mn = fmaxf(m_reg, pmax); alpha = __builtin_amdgcn_exp2f((m_reg - mn) * C2); m_reg = mn; }
    const float mnL = -mn * C2;
    for (int r = 0; r < 16; ++r) p0[r] = fmaf(p0[r], C2, mnL); for (int r = 0; r < 16; ++r) p1[r] = fmaf(p1[r], C2, mnL);
    for (int r = 0; r < 16; ++r) p0[r] = __builtin_amdgcn_exp2f(p0[r]);
}
__device__ __forceinline__ void finishSM(f32x16& p0, f32x16& p1, float alpha, float& l_reg, bf16x8& pa0, bf16x8& pa1, bf16x8& pa2, bf16x8& pa3) {
    for (int r = 0; r < 16; ++r) p1[r] = __builtin_amdgcn_exp2f(p1[r]);
    float ps = 0; for (int r = 0; r < 16; ++r) ps += p0[r]; for (int r = 0; r < 16; ++r) ps += p1[r];
    { auto rr = __builtin_amdgcn_permlane32_swap(__float_as_uint(ps), __float_as_uint(ps), false, false);
      ps = __uint_as_float(rr[0]) + __uint_as_float(rr[1]); }
    l_reg = l_reg * alpha + ps;
#define PK4(P, B_, OUT) do { unsigned a0 = cvtpk(P[B_+0], P[B_+1]), a1 = cvtpk(P[B_+2], P[B_+3]);                          \
        unsigned b0 = cvtpk(P[B_+4], P[B_+5]), b1 = cvtpk(P[B_+6], P[B_+7]);                                             \
        auto r0 = __builtin_amdgcn_permlane32_swap(a0, b0, false, false); auto r1 = __builtin_amdgcn_permlane32_swap(a1, b1, false, false); \
        u32x4 w = {r0[0], r1[0], r0[1], r1[1]}; OUT = *reinterpret_cast<bf16x8*>(&w); } while (0)
    PK4(p0, 0, pa0); PK4(p0, 8, pa1); PK4(p1, 0, pa2); PK4(p1, 8, pa3);
#undef PK4
}
template <int KB, bool SK>
__device__ __forceinline__ void qkt(f32x16& p0, f32x16& p1, const char* K_lds, int r32, int hi, const bf16x8* qr, bool act) {
    if (SK && !act) { const float NEG = -__builtin_inff();
#pragma unroll
        for (int r = 0; r < 16; ++r) { p0[r] = NEG; p1[r] = NEG; } return; }
    p0 = f32x16{}; p1 = f32x16{};
    const char* kb[4];
#pragma unroll
    for (int dd = 0; dd < 4; ++dd) kb[dd] = K_lds + KB * SHM_K + KSWZ(r32, (dd * 16 + hi * 8) * 2);
#pragma unroll
    for (int d0 = 0; d0 < 8; ++d0) { const char* a = kb[d0 & 3] + (d0 >> 2) * 128;
        bf16x8 b0 = *reinterpret_cast<const bf16x8*>(a);
        bf16x8 b1 = *reinterpret_cast<const bf16x8*>(a + 32 * 256);
        p0 = __builtin_amdgcn_mfma_f32_32x32x16_bf16(b0, qr[d0], p0, 0, 0, 0);
        p1 = __builtin_amdgcn_mfma_f32_32x32x16_bf16(b1, qr[d0], p1, 0, 0, 0); }
}
template <int VB, bool SK>
__device__ __forceinline__ void pv_tile(f32x16* o, int vb0, bf16x8 pa0, bf16x8 pa1, bf16x8 pa2, bf16x8 pa3, bool act) {
    if (SK && !act) return;
#define TRRD(dst, off) asm volatile("ds_read_b64_tr_b16 %0, %1 offset:%2" : "=&v"(dst) : "v"(vb0), "i"(off) : "memory")
#define PV_D0(d0) do { s16x4 l0, l1, l2, l3, h0, h1, h2, h3; constexpr int b_ = VB * SHM_V + v_rd_off(d0, 0, 0);     \
        TRRD(l0, b_); TRRD(h0, b_ + 2048); TRRD(l1, b_ + 4096); TRRD(h1, b_ + 6144); TRRD(l2, b_ + 8192); TRRD(h2, b_ + 10240); TRRD(l3, b_ + 12288); TRRD(h3, b_ + 14336); \
        asm volatile("s_waitcnt lgkmcnt(0)" ::: "memory"); SBAR();                 \
        o[d0] = __builtin_amdgcn_mfma_f32_32x32x16_bf16(pa0, (bf16x8){l0[0], l0[1], l0[2], l0[3], h0[0], h0[1], h0[2], h0[3]}, o[d0], 0, 0, 0);   \
        o[d0] = __builtin_amdgcn_mfma_f32_32x32x16_bf16(pa1, (bf16x8){l1[0], l1[1], l1[2], l1[3], h1[0], h1[1], h1[2], h1[3]}, o[d0], 0, 0, 0);   \
        o[d0] = __builtin_amdgcn_mfma_f32_32x32x16_bf16(pa2, (bf16x8){l2[0], l2[1], l2[2], l2[3], h2[0], h2[1], h2[2], h2[3]}, o[d0], 0, 0, 0);   \
        o[d0] = __builtin_amdgcn_mfma_f32_32x32x16_bf16(pa3, (bf16x8){l3[0], l3[1], l3[2], l3[3], h3[0], h3[1], h3[2], h3[3]}, o[d0], 0, 0, 0); } while (0)
    PV_D0(0); PV_D0(1); PV_D0(2); PV_D0(3);
#undef PV_D0
#undef TRRD
}

template <class TIn, class TOut> struct BlockRef { const TIn* Q; const TIn* K; const TIn* V; TOut* O; float* L; int P0; int pitch; int lpitch; };
template <class TIn> struct Seam {
    bf16x8 qr[8];
    bf16x8 st_v0, st_v1, st_k0, st_k1; f32x4 sf0, sf1, sf2, sf3;
    f32x4 tq[16];
};
__device__ __forceinline__ int swa_jlo(int P0, int W) { const int lowk = P0 - W + 1; return lowk > 0 ? lowk / KVBLK : 0; }
#define ROWP(p, k0, rr, pt) ((p) + (size_t)((k0) + (rr)) * (size_t)(pt) + sc)
#define ROW(p, k0, rr) ROWP(p, k0, rr, rowp_)
#define VMW() asm volatile("s_waitcnt vmcnt(0)" ::: "memory")
#define VMWN(n) asm volatile("s_waitcnt vmcnt(%0)" :: "i"(n) : "memory")
#define SLOAD_HP(Kp, Vp, k0, pt) do { S.st_v0 = load8<TIn>(ROWP(Vp, k0, sr, pt)); S.st_v1 = load8<TIn>(ROWP(Vp, k0, 32 + sr, pt));              \
                         S.st_k0 = load8<TIn>(ROWP(Kp, k0, sr, pt)); S.st_k1 = load8<TIn>(ROWP(Kp, k0, 32 + sr, pt)); } while (0)
#define SLOAD_H(Kp, Vp, k0) SLOAD_HP(Kp, Vp, k0, rowp_)
#define SWRITE_HK(bf) do { *(bf16x8*)(K_lds + (bf) * SHM_K + kws) = S.st_k0; *(bf16x8*)(K_lds + (bf) * SHM_K + kws + 32 * 256) = S.st_k1; } while (0)
#define SWRITE_HV(bf) do { *(bf16x8*)(V_lds + (bf) * SHM_V + vst0) = S.st_v0; *(bf16x8*)(V_lds + (bf) * SHM_V + vst1) = S.st_v1; } while (0)
#define SWRITE_H(bf) do { SWRITE_HV(bf); SWRITE_HK(bf); } while (0)
#define SLOAD_F(p, k0) do { S.sf0 = *(const f32x4*)ROW(p, k0, sr); S.sf1 = *(const f32x4*)(ROW(p, k0, sr) + 4);                \
                            S.sf2 = *(const f32x4*)ROW(p, k0, 32 + sr); S.sf3 = *(const f32x4*)(ROW(p, k0, 32 + sr) + 4); } while (0)
#define SWRITE_KF(bf) do { *(bf16x8*)(K_lds + (bf) * SHM_K + kws) = pack8(S.sf0, S.sf1); *(bf16x8*)(K_lds + (bf) * SHM_K + kws + 32 * 256) = pack8(S.sf2, S.sf3); } while (0)
#define SWRITE_VF(bf) do { *(bf16x8*)(V_lds + (bf) * SHM_V + vst0) = pack8(S.sf0, S.sf1); *(bf16x8*)(V_lds + (bf) * SHM_V + vst1) = pack8(S.sf2, S.sf3); } while (0)
template <class TIn, class TOut>
__device__ __forceinline__ void causal_swa_prime(const BlockRef<TIn, TOut>& cur, int W, char* lds, Seam<TIn>& S) {
    constexpr bool F32 = same_t<TIn, float>::v;
    const int tid = ltid(), wid = __builtin_amdgcn_readfirstlane(tid >> 6), lane = tid & 63, r32 = lane & 31, hi = lane >> 5;
    const int sr = tid >> 4, sc = (tid & 15) * 8, kws = KSWZ(sr, sc * 2); char* K_lds = lds + 2 * SHM_V;
    const int kb0 = swa_jlo(cur.P0, W) * KVBLK; const int rowp_ = cur.pitch;
    for (int d0 = 0; d0 < 8; ++d0) S.qr[d0] = load8<TIn>(cur.Q + (size_t)(wid * QBLK + r32) * (size_t)cur.pitch + d0 * 16 + hi * 8);
    if constexpr (F32) { SLOAD_F((const float*)cur.K, kb0); VMW(); SWRITE_KF(0); SBAR(); SLOAD_F((const float*)cur.V, kb0); }
    else { SLOAD_H(cur.K, cur.V, kb0); VMW(); SWRITE_HK(0); }
    __syncthreads();
}
template <class TIn, class TOut>
__device__ __forceinline__ void causal_swa_block(const BlockRef<TIn, TOut>& cur, const BlockRef<TIn, TOut>& nxt, int skv, int W, char* lds, Seam<TIn>& S) {
    constexpr bool F32 = same_t<TIn, float>::v;
    const int tid = ltid(), wid = __builtin_amdgcn_readfirstlane(tid >> 6), lane = tid & 63, r32 = lane & 31, hi = lane >> 5;
    const int j_lo = swa_jlo(cur.P0, W); const int rowp_ = cur.pitch;
    int j_hi = (cur.P0 + QB - 1) / KVBLK + 1; if (j_hi > skv / KVBLK) j_hi = skv / KVBLK;
    const int NT = j_hi - j_lo;
    const int kbn = swa_jlo(nxt.P0, W) * KVBLK;
    const int qlo = cur.P0 + wid * QBLK, qm = qlo + r32 - 4 * hi;
    char* V_lds = lds; char* K_lds = lds + 2 * SHM_V;
    float* ws = (float*)(lds + 2 * SHM_V + 2 * SHM_K) + wid * 64; float* li_l = ws, * al_l = ws + 32;
    float m_reg = -1e30f, l_reg = 0; f32x16 o[4] = {};
    const int sr = tid >> 4, sc = (tid & 15) * 8, vst0 = v_st(sr, sc), vst1 = v_st(32 + sr, sc), kws = KSWZ(sr, sc * 2);
    const int vb0 = (int)(uintptr_t)V_lds + v_rd_base(lane);
    const TIn* Kh = cur.K; const TIn* Vh = cur.V;
#define RESC(a) do { if (__any((a) < 1.f)) { if (hi == 0) al_l[r32] = (a); asm volatile("s_waitcnt lgkmcnt(0)" ::: "memory");              \
                     for (int d_ = 0; d_ < 4; ++d_) for (int r = 0; r < 16; ++r) o[d_][r] *= al_l[crow(r, hi)]; } } while (0)
#define KBASE(t) ((j_lo + (t)) * KVBLK)
#define ACT(t) (KBASE(t) <= qlo + QBLK - 1 && KBASE(t) + KVBLK - 1 >= qlo - W + 1)
#define MASKT(P0_, P1_, t) do { const int kb_ = KBASE(t); if ((!SK || ACT(t)) && (kb_ + KVBLK - 1 > qlo || kb_ <= qlo + QBLK - 1 - W)) mask_tile(P0_, P1_, qm - kb_, (unsigned)W); } while (0)
    constexpr int NQL = F32 ? 16 : 8;
    constexpr bool SK = WSKIP && !F32;
#define SEAM_K0() do { VMWN(NQL); if constexpr (F32) { SWRITE_KF(0); SBAR(); SLOAD_F((const float*)nxt.V, kbn); } else { SWRITE_HK(0); } SBAR(); } while (0)
    f32x16 pA0, pA1, pB0, pB1; float mnA, mnB, alA, alB; bf16x8 pa0, pa1, pa2, pa3;
    if constexpr (F32) { VMW(); SWRITE_VF(0); SBAR(); } else { SWRITE_HV(0); SBAR(); }
    if (NT > 1) { if constexpr (F32) SLOAD_F((const float*)Kh, KBASE(1)); else SLOAD_H(Kh, Vh, KBASE(1)); }
    SBAR(); qkt<0, SK>(pA0, pA1, K_lds, r32, hi, S.qr, ACT(0));
    if constexpr (F32) { if (NT > 1) { VMW(); SWRITE_KF(1); SBAR(); SLOAD_F((const float*)Vh, KBASE(1)); } }
    MASKT(pA0, pA1, 0); partialSM(pA0, pA1, m_reg, mnA, alA);
    if (NT > 1) { VMW(); if constexpr (F32) { SWRITE_VF(1); SBAR(); if (NT > 2) SLOAD_F((const float*)Kh, KBASE(2)); } else SWRITE_H(1); }
    __syncthreads();
#define HALF_STEP(PX0, PX1, mnX, alX, PY0, PY1, alY, t, KB, VB, SB) do {                                                      \
        SBAR(); qkt<KB, SK>(PX0, PX1, K_lds, r32, hi, S.qr, ACT(t));                                             \
        finishSM(PY0, PY1, alY, l_reg, pa0, pa1, pa2, pa3); SBAR();                                                           \
        if ((t) + 1 < NT) { if constexpr (F32) { VMW(); SWRITE_KF(SB); SBAR(); SLOAD_F((const float*)Vh, KBASE((t) + 1)); }  \
                            else { SLOAD_H(Kh, Vh, KBASE((t) + 1)); } SBAR(); }                                               \
        pv_tile<VB, SK>(o, vb0, pa0, pa1, pa2, pa3, ACT((t) - 1)); MASKT(PX0, PX1, (t)); partialSM(PX0, PX1, m_reg, mnX, alX);                                        \
        __syncthreads();                                                                                                      \
        if ((t) + 1 < NT) { VMW(); if constexpr (F32) { SWRITE_VF(SB); SBAR(); if ((t) + 2 < NT) SLOAD_F((const float*)Kh, KBASE((t) + 2)); } \
                            else { SWRITE_H(SB); } }                                                                          \
        RESC(alX); __syncthreads(); } while (0)
    for (int t = 1; t + 1 < NT; t += 2) {
        HALF_STEP(pB0, pB1, mnB, alB, pA0, pA1, alA, t, 1, 0, 0);
        HALF_STEP(pA0, pA1, mnA, alA, pB0, pB1, alB, t + 1, 0, 1, 1);
    }
    const bool even = (NT & 1) == 0;
    if (even) { SBAR(); qkt<1, SK>(pB0, pB1, K_lds, r32, hi, S.qr, ACT(NT - 1)); SBAR(); }
#define QROW(e) (nxt.Q + (size_t)(wid * QBLK + r32) * (size_t)nxt.pitch + ((e) >> 1) * 16 + hi * 8 + ((e) & 1) * 4)
    if constexpr (F32) { SLOAD_F((const float*)nxt.K, kbn); SBAR();
#pragma unroll
        for (int e = 0; e < 8; ++e) S.tq[e] = *(const f32x4*)QROW(e); }
    else { SLOAD_HP(nxt.K, nxt.V, kbn, nxt.pitch); SBAR();
#pragma unroll
        for (int d0 = 0; d0 < 8; ++d0) S.qr[d0] = load8<TIn>(nxt.Q + (size_t)(wid * QBLK + r32) * (size_t)nxt.pitch + d0 * 16 + hi * 8); }
    SBAR();
    finishSM(pA0, pA1, alA, l_reg, pa0, pa1, pa2, pa3); SBAR();
    if constexpr (F32) {
#pragma unroll
        for (int e = 8; e < 16; ++e) S.tq[e] = *(const f32x4*)QROW(e); SBAR(); }
#undef QROW
    pv_tile<0, SK>(o, vb0, pa0, pa1, pa2, pa3, ACT(even ? NT - 2 : NT - 1));
    if (even) { MASKT(pB0, pB1, NT - 1); partialSM(pB0, pB1, m_reg, mnB, alB); __syncthreads(); RESC(alB);
        finishSM(pB0, pB1, alB, l_reg, pa0, pa1, pa2, pa3); SBAR(); pv_tile<1, SK>(o, vb0, pa0, pa1, pa2, pa3, ACT(NT - 1)); }
    SBAR(); SEAM_K0();
    if (hi == 0) { li_l[r32] = l_reg; cur.L[(size_t)(wid * QBLK + r32) * (size_t)cur.lpitch] = m_reg * SCALE + __builtin_amdgcn_logf(l_reg) * 0.6931471805599453f; }
    asm volatile("s_waitcnt lgkmcnt(0)" ::: "memory");
    float rli[16];
#pragma unroll
    for (int r = 0; r < 16; ++r) rli[r] = __builtin_amdgcn_rcpf(li_l[crow(r, hi)]);
    TOut* Ow = cur.O + (size_t)(wid * QBLK) * (size_t)cur.pitch;
#pragma unroll
    for (int r = 0; r < 16; ++r) { const int orow = crow(r, hi);
#pragma unroll
        for (int d0 = 0; d0 < 4; ++d0) { const float v = o[d0][r] * rli[r];
            if constexpr (same_t<TOut, float>::v) { Ow[(size_t)orow * (size_t)cur.pitch + d0 * 32 + r32] = v; }
            else { const float vn = __shfl_xor(v, 1);
                   if ((r32 & 1) == 0) *(unsigned*)(Ow + (size_t)orow * (size_t)cur.pitch + d0 * 32 + r32) = cvtpk(v, vn); } } }
    if constexpr (F32) {
#pragma unroll
        for (int d0 = 0; d0 < 8; ++d0) S.qr[d0] = pack8(S.tq[2 * d0], S.tq[2 * d0 + 1]); }
    __syncthreads();
#undef RESC
#undef KBASE
#undef ACT
#undef MASKT
#undef SEAM_K0
#undef HALF_STEP
}
#undef ROW
#undef ROWP
#undef SLOAD_HP
#undef VMW
#undef VMWN
#undef SLOAD_H
#undef SWRITE_HK
#undef SWRITE_HV
#undef SWRITE_H
#undef SLOAD_F
#undef SWRITE_KF
#undef SWRITE_VF
}
#ifndef ONE_LAUNCH
#define ONE_LAUNCH 1
#endif
#ifndef PROBE_SKIP
#define PROBE_SKIP 0
#endif
#ifndef NPASS
#define NPASS 1
#endif
#ifndef PROBE_DUP_PROLOGUE
#define PROBE_DUP_PROLOGUE 0
#endif
constexpr int NBATCH = 4, SEQ = 4096, DM = 2048, M = NBATCH * SEQ, INW = 7168, DFF = 5632, DEPTH = 2;
constexpr int C_Q = 2048, C_K = 5120, C_V = 6144;
constexpr float EPS = 1e-6f;
constexpr int NWAVES = 8;
constexpr size_t MiB = 1u << 20;
constexpr size_t WS_CTL = 0, CTL_ZERO_BYTES = 1 * MiB;
constexpr int CW_BAR = 4096;
constexpr size_t WS_RSQ = 5 * MiB;
constexpr int RT_OFF = 131072 + 1024 + 8192;
constexpr int XL_OFF = 131072 + 1024;
constexpr int MISC_OFF = 131072 + 320;
constexpr size_t WS_ROPE = 1 * MiB;
constexpr size_t WS_LSE = 3 * MiB;
constexpr size_t WS_W = 8 * MiB;
constexpr size_t W_IN_OFF = 0, W_OUT_OFF = 28 * MiB, W_GU_OFF = 36 * MiB, W_DN_OFF = 80 * MiB, W_LAYER = 102 * MiB;
constexpr size_t WS_XN = WS_W + DEPTH * W_LAYER;
constexpr size_t WS_Z = WS_XN + 64 * MiB;
constexpr size_t WS_END = WS_Z + 224 * MiB;
static_assert((size_t)INW * DM * 2 == 28 * MiB && (size_t)DM * DM * 2 == 8 * MiB && (size_t)2 * DFF * DM * 2 == 44 * MiB && (size_t)DM * DFF * 2 == 22 * MiB, "weight map");
static_assert((size_t)M * DM * 2 == 64 * MiB && (size_t)M * INW * 2 == 224 * MiB && (size_t)M * DFF * 2 <= 224 * MiB, "activation map");
constexpr int LDS_BYTES = 147456;

#define LAS __attribute__((address_space(3)))
typedef unsigned short bf16_t;
typedef unsigned u32x4 __attribute__((ext_vector_type(4)));
typedef unsigned u32x2 __attribute__((ext_vector_type(2)));
typedef float f32x4 __attribute__((ext_vector_type(4)));
typedef short bf16x8 __attribute__((ext_vector_type(8)));
#define LDS_WAIT() asm volatile("s_waitcnt lgkmcnt(0)" ::: "memory")

__device__ __forceinline__ unsigned f2bf(float f) { unsigned u = __builtin_bit_cast(unsigned, f); return (u + 0x7fffu + ((u >> 16) & 1u)) >> 16; }
__device__ __forceinline__ unsigned pk2(float lo, float hi) { return pg8::cvt_pk_bf16(lo, hi); }
__device__ __forceinline__ float bf_lo(unsigned w) { return __builtin_bit_cast(float, w << 16); }
__device__ __forceinline__ float bf_hi(unsigned w) { return __builtin_bit_cast(float, w & 0xffff0000u); }
__device__ __forceinline__ float wave_sum(float v) {
#pragma unroll
    for (int o = 1; o < 64; o <<= 1) v += __shfl_xor(v, o);
    return v;
}

struct Args { const float* in[16]; float* out; unsigned char* ws; int ph_lo, ph_hi; };

__device__ __forceinline__ void transpose_item(const float* W, int K, int N, bf16_t* WT, int mode, const float* kscale, LAS float* scr, int item, int lane) {
    const int nblk = N / 32, kb = item / nblk, nb = item % nblk, k0 = 64 * kb, n0 = 32 * nb;
    const int drow = (mode == 0 || mode == 3) ? n0 : ((n0 >> 7) * 256 + (n0 & 127) + (mode == 2 ? 128 : 0));
    f32x4 t[8];
#pragma unroll
    for (int i = 0; i < 8; ++i) t[i] = *(const f32x4*)(W + (size_t)(k0 + 8 * i + (lane >> 3)) * N + n0 + 4 * (lane & 7));
#pragma unroll
    for (int i = 0; i < 8; ++i) { const int kk = 8 * i + (lane >> 3); const float sc = kscale ? kscale[k0 + kk] : 1.f; LAS float* d = scr + kk * 33 + 4 * (lane & 7);
        d[0] = t[i][0] * sc; d[1] = t[i][1] * sc; d[2] = t[i][2] * sc; d[3] = t[i][3] * sc; }
    LDS_WAIT(); asm volatile("" ::: "memory");
    const int c = lane & 7;
#pragma unroll
    for (int j = 0; j < 4; ++j) { const int n = (lane >> 3) + 8 * j; const LAS float* s = scr + (8 * c) * 33 + n;
        int dn = n;
        if (mode == 3 && n0 >= 2048 && n0 < 6144) { const int d = (n0 & 127) + n; dn = ((d >> 4) & 3) * 32 + ((d >> 2) & 3) * 8 + (d >> 6) * 4 + (d & 3) - (n0 & 127); }
        u32x4 o; o.x = pk2(s[0 * 33], s[1 * 33]); o.y = pk2(s[2 * 33], s[3 * 33]); o.z = pk2(s[4 * 33], s[5 * 33]); o.w = pk2(s[6 * 33], s[7 * 33]);
        *(u32x4*)(WT + (size_t)(drow + dn) * K + k0 + 8 * c) = o; }
    LDS_WAIT(); asm volatile("" ::: "memory");
}
__device__ __forceinline__ void convert_rows(const float* X, bf16_t* out, float* rsq, int gw, int ngw, int lane) {
    for (int m = gw; m < M; m += ngw) {
        const f32x4* xr = (const f32x4*)(X + (size_t)m * DM) + lane;
        f32x4 v[8]; float s = 0.f;
#pragma unroll
        for (int j = 0; j < 8; ++j) { v[j] = xr[64 * j]; s += (v[j].x * v[j].x + v[j].y * v[j].y) + (v[j].z * v[j].z + v[j].w * v[j].w); }
        s = wave_sum(s); if (lane == 0) rsq[m] = s;
        u32x2* o8 = (u32x2*)(out + (size_t)m * DM) + lane;
#pragma unroll
        for (int j = 0; j < 8; ++j) { u32x2 w; w.x = pk2(v[j].x, v[j].y); w.y = pk2(v[j].z, v[j].w); o8[64 * j] = w; }
    }
}
__device__ __forceinline__ void qk_prep(bf16_t* Z, const float* qn, const float* kn, const float* rope, int gw, int ngw, int lane) {
    const int i4 = 4 * (lane & 15);
    const f32x4 gq1 = *(const f32x4*)(qn + i4), gq2 = *(const f32x4*)(qn + 64 + i4), gk1 = *(const f32x4*)(kn + i4), gk2 = *(const f32x4*)(kn + 64 + i4);
    for (int it = gw; it < M * 8; it += 4 * ngw) {
        bf16_t* p[4]; u32x2 a[4], b[4]; f32x4 cs[4], sn[4]; bool ok[4], isq[4];
#pragma unroll
        for (int j = 0; j < 4; ++j) { const int itj = it + j * ngw; ok[j] = itj < M * 8; const int row = ok[j] ? itj >> 3 : 0, head = (itj & 7) * 4 + (lane >> 4); isq[j] = head < 24;
            p[j] = Z + (size_t)row * INW + C_Q + head * 128 + i4; const int pos = row & (SEQ - 1);
            a[j] = *(const u32x2*)p[j]; b[j] = *(const u32x2*)(p[j] + 64);
            cs[j] = *(const f32x4*)(rope + (size_t)pos * 64 + i4); sn[j] = *(const f32x4*)(rope + (size_t)SEQ * 64 + (size_t)pos * 64 + i4); }
#pragma unroll
        for (int j = 0; j < 4; ++j) {
            const float x1[4] = {bf_lo(a[j].x), bf_hi(a[j].x), bf_lo(a[j].y), bf_hi(a[j].y)}, x2[4] = {bf_lo(b[j].x), bf_hi(b[j].x), bf_lo(b[j].y), bf_hi(b[j].y)};
            float ss = (x1[0] * x1[0] + x1[1] * x1[1]) + (x1[2] * x1[2] + x1[3] * x1[3]) + (x2[0] * x2[0] + x2[1] * x2[1]) + (x2[2] * x2[2] + x2[3] * x2[3]);
            ss += __shfl_xor(ss, 1); ss += __shfl_xor(ss, 2); ss += __shfl_xor(ss, 4); ss += __shfl_xor(ss, 8);
            const float rstd = __builtin_amdgcn_rsqf(ss * (1.f / 128.f) + EPS);
            const f32x4 g1 = isq[j] ? gq1 : gk1, g2 = isq[j] ? gq2 : gk2;
            float o1[4], o2[4];
#pragma unroll
            for (int e = 0; e < 4; ++e) { const float y1 = x1[e] * rstd * g1[e], y2 = x2[e] * rstd * g2[e]; o1[e] = y1 * cs[j][e] - y2 * sn[j][e]; o2[e] = y2 * cs[j][e] + y1 * sn[j][e]; }
            u32x2 wa, wb; wa.x = pk2(o1[0], o1[1]); wa.y = pk2(o1[2], o1[3]); wb.x = pk2(o2[0], o2[1]); wb.y = pk2(o2[2], o2[3]);
            if (ok[j]) { *(u32x2*)p[j] = wa; *(u32x2*)(p[j] + 64) = wb; }
        }
    }
}
#define GMLP_DECL(P) u32x2 P##uu[8]; f32x4 P##w[8]; u32x4 P##raw[4]
#define GMLP_LOAD(P, Zp, wsp_, cidx_, g_) do { const int row0_ = (cidx_) * 128; \
    { const int wv_ = tid >> 6, ln_ = tid & 63; const bf16_t* up_ = (Zp) + (size_t)(row0_ + wv_ * 16 + (ln_ & 15)) * INW + (g_) * 128 + 4 * (ln_ >> 4); \
      _Pragma("unroll") for (int ct = 0; ct < 8; ++ct) P##uu[ct] = *(const u32x2*)(up_ + 16 * ct); } \
    { const float* wp_ = (wsp_) + ((size_t)(g_) * 128 + (tid >> 2)) * 128 + (tid & 3) * 32; \
      _Pragma("unroll") for (int q = 0; q < 8; ++q) P##w[q] = *(const f32x4*)(wp_ + 4 * q); } \
    { const bf16_t* vp_ = (Zp) + (size_t)(row0_ + (tid >> 2)) * INW + 1024 + (g_) * 128 + (tid & 3) * 32; \
      _Pragma("unroll") for (int q = 0; q < 4; ++q) P##raw[q] = *(const u32x4*)(vp_ + 8 * q); } \
    asm volatile("" ::: "memory"); } while (0)
__device__ __forceinline__ void gmlp_unit(LAS unsigned char* lds, bf16_t* Z, const float* ln_g, const float* ln_b, const float* b_s, const u32x2 (&uu)[8], const f32x4 (&wreg)[8], const u32x4 (&raw)[4], int cidx, int g, int tid) {
    constexpr int LSTR = 272;
    LAS unsigned char* VT = lds; LAS unsigned char* WS = lds + 128 * LSTR;
    const int row0 = cidx * 128;
    {
        const int j = tid >> 2, cq = (tid & 3) * 32;
        float x[32];
#pragma unroll
        for (int q = 0; q < 4; ++q)
#pragma unroll
            for (int e = 0; e < 4; ++e) { x[8 * q + 2 * e] = bf_lo(raw[q][e]); x[8 * q + 2 * e + 1] = bf_hi(raw[q][e]); }
        float s = 0.f;
#pragma unroll
        for (int c = 0; c < 32; ++c) s += x[c];
        s += __shfl_xor(s, 1); s += __shfl_xor(s, 2);
        const float mean = s * (1.f / 128.f); float q2 = 0.f;
#pragma unroll
        for (int c = 0; c < 32; ++c) { x[c] -= mean; q2 += x[c] * x[c]; }
        q2 += __shfl_xor(q2, 1); q2 += __shfl_xor(q2, 2);
        const float rstd = __builtin_amdgcn_rsqf(q2 * (1.f / 128.f) + EPS);
        const float* gp = ln_g + g * 128 + cq; const float* bp = ln_b + g * 128 + cq;
#pragma unroll
        for (int c4 = 0; c4 < 8; ++c4) { const f32x4 gg = *(const f32x4*)(gp + 4 * c4), bb = *(const f32x4*)(bp + 4 * c4);
#pragma unroll
            for (int e = 0; e < 4; ++e) { const int c = 4 * c4 + e; const float y = x[c] * rstd * gg[e] + bb[e];
                *(LAS unsigned short*)(VT + (cq + c) * LSTR + j * 2) = (unsigned short)f2bf(y); } }
    }
    {
        const int i = tid >> 2, jq = (tid & 3) * 32;
#pragma unroll
        for (int q = 0; q < 4; ++q) { f32x4 a = wreg[2 * q], b = wreg[2 * q + 1];
            const int j0 = jq + 8 * q;
#pragma unroll
            for (int e = 0; e < 4; ++e) { if (j0 + e > i) a[e] = 0.f; if (j0 + 4 + e > i) b[e] = 0.f; }
            u32x4 w; w.x = pk2(a[0], a[1]); w.y = pk2(a[2], a[3]); w.z = pk2(b[0], b[1]); w.w = pk2(b[2], b[3]);
            *(LAS u32x4*)(WS + i * LSTR + j0 * 2) = w; }
    }
    __syncthreads();
    const int wv = tid >> 6, lane = tid & 63, fr = lane & 15, fq = lane >> 4;
    f32x4 acc[8];
#pragma unroll
    for (int ct = 0; ct < 8; ++ct) acc[ct] = (f32x4){0.f, 0.f, 0.f, 0.f};
#pragma unroll
    for (int ks = 0; ks < 4; ++ks) {
        const bf16x8 bw = *(const LAS bf16x8*)(WS + (wv * 16 + fr) * LSTR + (ks * 32 + fq * 8) * 2);
#pragma unroll
        for (int ct = 0; ct < 8; ++ct) { const bf16x8 av = *(const LAS bf16x8*)(VT + (ct * 16 + fr) * LSTR + (ks * 32 + fq * 8) * 2);
            acc[ct] = __builtin_amdgcn_mfma_f32_16x16x32_bf16(av, bw, acc[ct], 0, 0, 0); }
    }
    {
        const int i = wv * 16 + fr; const float bs = b_s[g * 128 + i];
        bf16_t* up = Z + (size_t)(row0 + i) * INW + g * 128 + 4 * fq;
#pragma unroll
        for (int ct = 0; ct < 8; ++ct) {
            u32x2 w; w.x = pk2(bf_lo(uu[ct].x) * (acc[ct][0] + bs), bf_hi(uu[ct].x) * (acc[ct][1] + bs)); w.y = pk2(bf_lo(uu[ct].y) * (acc[ct][2] + bs), bf_hi(uu[ct].y) * (acc[ct][3] + bs));
            *(u32x2*)(up + 16 * ct) = w; }
    }
    __syncthreads();
}
__device__ __forceinline__ void merge_rows(bf16_t* Z, const float* LSE, const float* ga, const float* gb, int gw, int ngw, int lane) {
    const int ch0 = lane * 16, head = lane >> 3;
    f32x4 gav[2][2], gbv[2][2];
#pragma unroll
    for (int h2 = 0; h2 < 2; ++h2) { gav[h2][0] = *(const f32x4*)(ga + ch0 + 8 * h2); gav[h2][1] = *(const f32x4*)(ga + ch0 + 8 * h2 + 4); gbv[h2][0] = *(const f32x4*)(gb + ch0 + 8 * h2); gbv[h2][1] = *(const f32x4*)(gb + ch0 + 8 * h2 + 4); }
    for (int m0 = gw; m0 < M; m0 += 2 * ngw) {
        u32x4 q0[2][2], q1[2][2], q2[2][2], aa[2][2]; float l0[2], l1[2], l2[2]; bool ok[2];
#pragma unroll
        for (int r = 0; r < 2; ++r) { const int m = m0 + r * ngw; ok[r] = m < M; const int mm = ok[r] ? m : m0; const bf16_t* zr = Z + (size_t)mm * INW;
            l0[r] = LSE[((size_t)0 * M + mm) * 8 + head]; l1[r] = LSE[((size_t)1 * M + mm) * 8 + head]; l2[r] = LSE[((size_t)2 * M + mm) * 8 + head];
#pragma unroll
            for (int h2 = 0; h2 < 2; ++h2) { q0[r][h2] = *(const u32x4*)(zr + C_Q + ch0 + 8 * h2); q1[r][h2] = *(const u32x4*)(zr + C_Q + 1024 + ch0 + 8 * h2); q2[r][h2] = *(const u32x4*)(zr + C_Q + 2048 + ch0 + 8 * h2); aa[r][h2] = *(const u32x4*)(zr + ch0 + 8 * h2); } }
#pragma unroll
        for (int r = 0; r < 2; ++r) {
            const float mx = fmaxf(l0[r], fmaxf(l1[r], l2[r]));
            float e0 = __builtin_amdgcn_exp2f((l0[r] - mx) * 1.4426950408889634f), e1 = __builtin_amdgcn_exp2f((l1[r] - mx) * 1.4426950408889634f), e2 = __builtin_amdgcn_exp2f((l2[r] - mx) * 1.4426950408889634f);
            const float inv = __builtin_amdgcn_rcpf(e0 + e1 + e2); e0 *= inv; e1 *= inv; e2 *= inv;
            float ob[16], oa[16];
#pragma unroll
            for (int h2 = 0; h2 < 2; ++h2)
#pragma unroll
                for (int e = 0; e < 4; ++e) {
                    ob[8 * h2 + 2 * e] = e0 * bf_lo(q0[r][h2][e]) + e1 * bf_lo(q1[r][h2][e]) + e2 * bf_lo(q2[r][h2][e]); ob[8 * h2 + 2 * e + 1] = e0 * bf_hi(q0[r][h2][e]) + e1 * bf_hi(q1[r][h2][e]) + e2 * bf_hi(q2[r][h2][e]);
                    oa[8 * h2 + 2 * e] = bf_lo(aa[r][h2][e]); oa[8 * h2 + 2 * e + 1] = bf_hi(aa[r][h2][e]); }
            float sb = 0.f, sa = 0.f;
#pragma unroll
            for (int c = 0; c < 16; ++c) { sb += ob[c] * ob[c]; sa += oa[c] * oa[c]; }
            sb = wave_sum(sb); sa = wave_sum(sa);
            const float rb = __builtin_amdgcn_rsqf(sb * (1.f / 1024.f) + EPS), ra = __builtin_amdgcn_rsqf(sa * (1.f / 1024.f) + EPS);
            bf16_t* mr = Z + (size_t)(m0 + r * ngw) * INW;
            if (ok[r]) {
#pragma unroll
                for (int h2 = 0; h2 < 2; ++h2) {
                    const f32x4 ga0 = gav[h2][0], ga1 = gav[h2][1], gb0 = gbv[h2][0], gb1 = gbv[h2][1];
                    u32x4 wa, wb; const float* A = oa + 8 * h2; const float* B = ob + 8 * h2;
                    wa.x = pk2(A[0] * ra * ga0[0], A[1] * ra * ga0[1]); wa.y = pk2(A[2] * ra * ga0[2], A[3] * ra * ga0[3]); wa.z = pk2(A[4] * ra * ga1[0], A[5] * ra * ga1[1]); wa.w = pk2(A[6] * ra * ga1[2], A[7] * ra * ga1[3]);
                    wb.x = pk2(B[0] * rb * gb0[0], B[1] * rb * gb0[1]); wb.y = pk2(B[2] * rb * gb0[2], B[3] * rb * gb0[3]); wb.z = pk2(B[4] * rb * gb1[0], B[5] * rb * gb1[1]); wb.w = pk2(B[6] * rb * gb1[2], B[7] * rb * gb1[3]);
                    *(u32x4*)(mr + ch0 + 8 * h2) = wa; *(u32x4*)(mr + 1024 + ch0 + 8 * h2) = wb;
                }
            }
        }
    }
}
typedef swa::BlockRef<__hip_bfloat16, __hip_bfloat16> ABlock;
__device__ __forceinline__ ABlock attn_ref(int id, bf16_t* Zb, float* LSE) {
    __hip_bfloat16* Z = (__hip_bfloat16*)Zb;
    const int bh = id / 48, w48 = id - bh * 48, g = w48 >> 4, w16 = w48 & 15, b = bh >> 3, h = bh & 7;
    const int r = 1 << (2 * g), nqb = 16 >> (2 * g), rho = w16 / nqb, qb = w16 - rho * nqb;
    const size_t tok0 = (size_t)b * SEQ + rho, tokq = tok0 + (size_t)r * 256 * qb;
    ABlock R;
    R.K = Z + tok0 * INW + C_K + h * 128; R.V = Z + tok0 * INW + C_V + h * 128;
    R.Q = Z + tokq * INW + C_Q + g * 1024 + h * 128; R.O = Z + tokq * INW + C_Q + g * 1024 + h * 128;
    R.L = LSE + ((size_t)g * M + tokq) * 8 + h; R.P0 = 256 * qb; R.pitch = r * INW; R.lpitch = r * 8;
    return R;
}

#define RLX_AGENT __ATOMIC_RELAXED, __HIP_MEMORY_SCOPE_AGENT
#define XB_TMO      128
#define XB_XCNT(j)  (256  + 64 * (j))
#define XB_XSUB(j)  (1280 + 64 * (j))
#define XB_XGEN(j)  (2304 + 64 * (j))
#define XB_TOP      3328
#define XB_TOPGEN   3392
#define XCD_BAR_WORDS 3456
#define XB_SPIN_CAP (1u << 18)

__device__ __forceinline__ unsigned xb_ld(unsigned* p)              { return __hip_atomic_load(p, __ATOMIC_RELAXED, __HIP_MEMORY_SCOPE_AGENT); }
__device__ __forceinline__ unsigned xb_add(unsigned* p, unsigned v) { return __hip_atomic_fetch_add(p, v, __ATOMIC_RELAXED, __HIP_MEMORY_SCOPE_AGENT); }
__device__ __forceinline__ unsigned xb_xcc_id() { return (unsigned)__builtin_amdgcn_s_getreg((3 << 11) | 20) & 0xFu; }
#define XB_SPIN(cond, bar) do { unsigned _sp = 0; while (cond) { __builtin_amdgcn_s_sleep(1); \
    if ((++_sp & 255u) == 0u) { if (xb_ld(&(bar)[XB_TMO])) break; if (_sp > XB_SPIN_CAP) { atomicAdd(&(bar)[XB_TMO], 1u); break; } } } } while (0)

struct XcdBarrier {
    unsigned* bar; unsigned x;
    volatile LAS unsigned* st;
};

__device__ __forceinline__ XcdBarrier xcd_barrier_post(unsigned* bar, volatile LAS unsigned* st) {
    XcdBarrier b; b.bar = bar; b.x = xb_xcc_id(); b.st = st;
    if (threadIdx.x == 0) (void)xb_add(&bar[XB_XCNT(b.x)], 1u);
    return b;
}
__device__ __forceinline__ void xcd_barrier_complete(unsigned* bar, unsigned x, unsigned& nloc, unsigned& nx) {
    const unsigned G = gridDim.x * gridDim.y * gridDim.z;
    unsigned sum, cnt, mine, sp = 0u;
    for (;;) {
        sum = 0u; cnt = 0u; mine = 0u;
#pragma unroll
        for (unsigned j = 0; j < 16; ++j) { const unsigned c = xb_ld(&bar[XB_XCNT(j)]); sum += c; cnt += (c > 0u) ? 1u : 0u; mine = (j == x) ? c : mine; }
        if (sum == G) break;
        __builtin_amdgcn_s_sleep(1);
        if ((++sp & 255u) == 0u) { if (xb_ld(&bar[XB_TMO])) break; if (sp > XB_SPIN_CAP) { atomicAdd(&bar[XB_TMO], 1u); break; } }
    }
    nloc = mine > 0u ? mine : 1u; nx = cnt > 0u ? cnt : 1u;
}

__device__ __forceinline__ void xcd_barrier(const XcdBarrier& b) {
    asm volatile("s_waitcnt vmcnt(0)" ::: "memory");
    __syncthreads();
    if (threadIdx.x == 0) {
        unsigned* bar = b.bar;
        __builtin_amdgcn_s_waitcnt(0);
        unsigned nloc = b.st[0], nx = b.st[1];
        if (nloc == 0u) { xcd_barrier_complete(bar, b.x, nloc, nx); b.st[0] = nloc; b.st[1] = nx; }
        const unsigned old = xb_add(&bar[XB_XSUB(b.x)], 1u);
        const unsigned gen = old / nloc;
        if (old + 1u == (gen + 1u) * nloc) {
            __builtin_amdgcn_fence(__ATOMIC_RELEASE, "agent");
            asm volatile("s_waitcnt vmcnt(0)" ::: "memory");
            const unsigned og = xb_add(&bar[XB_TOP], 1u);
            const unsigned tg = og / nx;
            if (og + 1u == (tg + 1u) * nx) xb_add(&bar[XB_TOPGEN], 1u);
            else XB_SPIN(xb_ld(&bar[XB_TOPGEN]) == tg, bar);
            __builtin_amdgcn_fence(__ATOMIC_ACQUIRE, "agent");
            xb_add(&bar[XB_XGEN(b.x)], 1u);
            asm volatile("s_waitcnt vmcnt(0)" ::: "memory");
        } else {
            XB_SPIN(xb_ld(&bar[XB_XGEN(b.x)]) == gen, bar);
            __builtin_amdgcn_fence(__ATOMIC_ACQUIRE, "agent");
            asm volatile("s_waitcnt vmcnt(0)" ::: "memory");
        }
    }
    __syncthreads();
}

constexpr int PH_PER_LAYER = 7, N_PHASES = 1 + DEPTH * PH_PER_LAYER;
typedef const __attribute__((address_space(4))) Args* KArgs;
#define KARGS(A) KArgs A = (KArgs)__builtin_amdgcn_kernarg_segment_ptr(); asm volatile("" : "+s"(A))
#define PH_COMMON() KARGS(A); const int tid = ltid(), lane = tid & 63, wave = __builtin_amdgcn_readfirstlane(tid >> 6); const int G = gridDim.x, gw = blockIdx.x * NWAVES + wave, ngw = G * NWAVES; \
    unsigned char* ws = A->ws; (void)lane; (void)gw; (void)ngw; (void)ws
__global__ void __launch_bounds__(NWAVES * 64, 2) fwd_kernel(Args args_) {
    extern __shared__ __attribute__((aligned(16))) unsigned char lds[];
    int ph, ph_hi; { KARGS(A0); ph = A0->ph_lo; ph_hi = A0->ph_hi; }
#if ONE_LAUNCH
    { LAS unsigned* misc = (LAS unsigned*)((LAS unsigned char*)lds + MISC_OFF); if (threadIdx.x < 32) misc[threadIdx.x] = 0u; __syncthreads();
      KARGS(A0); (void)xcd_barrier_post((unsigned*)(A0->ws + WS_CTL) + CW_BAR, (volatile LAS unsigned*)(misc + 8)); }
#endif
#pragma unroll 1
    for (; ph < ph_hi; ++ph) {
#if NPASS > 1
        const int pe = ph >= N_PHASES ? ph - N_PHASES : ph;
        if (ph == N_PHASES) { KARGS(Az); float* rz = (float*)(Az->ws + WS_RSQ) + M; for (int i = blockIdx.x * 512 + threadIdx.x; i < 3 * M; i += gridDim.x * 512) rz[i] = 0.f; }
#else
        const int pe = ph;
#endif
        const int l = pe == 0 ? 0 : (pe - 1) / PH_PER_LAYER, s = pe == 0 ? -1 : (pe - 1) % PH_PER_LAYER;
        switch ((NPASS > 1 && ph < N_PHASES && ((PROBE_SKIP >> (s + 1)) & 1)) ? 99 : s) {
        case -1: for (int rep_ = 0; rep_ <= PROBE_DUP_PROLOGUE; ++rep_) {
            PH_COMMON(); LAS unsigned char* lds3 = (LAS unsigned char*)lds;
            LAS float* scr = (LAS float*)(lds3 + wave * 16384);
            constexpr int I_IN = (DM / 64) * (INW / 32), I_OUT = (DM / 64) * (DM / 32), I_G = (DM / 64) * (DFF / 32), I_D = (DFF / 64) * (DM / 32), I_L = I_IN + I_OUT + 2 * I_G + I_D;
            for (int it = gw; it < DEPTH * I_L; it += ngw) {
                const int li = it / I_L; int r = it - li * I_L; unsigned char* wd = ws + WS_W + (size_t)li * W_LAYER;
                if (r < I_IN) { transpose_item(A->in[2] + (size_t)li * DM * INW, DM, INW, (bf16_t*)(wd + W_IN_OFF), 3, A->in[1] + (size_t)li * DM, scr, r, lane); continue; } r -= I_IN;
                if (r < I_OUT) { transpose_item(A->in[11] + (size_t)li * DM * DM, DM, DM, (bf16_t*)(wd + W_OUT_OFF), 0, nullptr, scr, r, lane); continue; } r -= I_OUT;
                if (r < I_G) { transpose_item(A->in[13] + (size_t)li * DM * DFF, DM, DFF, (bf16_t*)(wd + W_GU_OFF), 1, A->in[12] + (size_t)li * DM, scr, r, lane); continue; } r -= I_G;
                if (r < I_G) { transpose_item(A->in[14] + (size_t)li * DM * DFF, DM, DFF, (bf16_t*)(wd + W_GU_OFF), 2, A->in[12] + (size_t)li * DM, scr, r, lane); continue; } r -= I_G;
                transpose_item(A->in[15] + (size_t)li * DFF * DM, DFF, DM, (bf16_t*)(wd + W_DN_OFF), 0, nullptr, scr, r, lane);
            }
            float* rope = (float*)(ws + WS_ROPE);
            for (int e = blockIdx.x * (NWAVES * 64) + tid; e < SEQ * 64; e += G * NWAVES * 64) {
                const int pos = e >> 6, i = e & 63;
                const float inv_freq = __builtin_amdgcn_exp2f(-(float)(2 * i) * (1.0f / 128.0f) * 13.287712379549449f);
                const float ang = (float)pos * inv_freq;
                double rev = (double)ang * 0.15915494309189535; rev -= __builtin_rint(rev);
                ((unsigned*)rope)[e] = pk2(__builtin_amdgcn_cosf((float)rev), __builtin_amdgcn_sinf((float)rev));
            }
            convert_rows(A->in[0], (bf16_t*)(ws + WS_XN), (float*)(ws + WS_RSQ), gw, ngw, lane);
        } break;
#ifndef NO_G1
        case 0: {
            PH_COMMON();
            pg8::Gemm g{(const bf16_t*)(ws + WS_XN), (const bf16_t*)(ws + WS_W + (size_t)l * W_LAYER + W_IN_OFF), M, INW, DM, DM}; pg8::StaticOrder S; S.init(M, INW, G, (int)blockIdx.x);
            pg8::RowScale rsc{(const float*)(ws + WS_RSQ) + (size_t)(l == 0 ? 0 : 2) * 8 * M, l == 0 ? 1 : 8, M, (LAS float*)((LAS unsigned char*)lds + RT_OFF)};
            pg8::EpiZ E{(bf16_t*)(ws + WS_Z), INW, rsc, A->in[7] + (size_t)l * 128, A->in[8] + (size_t)l * 128, (const float*)(ws + WS_ROPE), (LAS float*)((LAS unsigned char*)lds + XL_OFF)};
            pg8::gemm_phase<pg8::EpiZ, pg8::StaticOrder, true, true>((LAS unsigned char*)lds, g, S, E);
        } break;
#endif
#ifndef NO_MIX
        case 1: {
            PH_COMMON(); bf16_t* Z = (bf16_t*)(ws + WS_Z);
            const float* lng = A->in[3] + (size_t)l * 1024; const float* lnb = A->in[4] + (size_t)l * 1024;
            const float* wsp = A->in[5] + (size_t)l * 8 * 128 * 128; const float* bsp = A->in[6] + (size_t)l * 1024;
            {
                const int u0 = blockIdx.x, u1 = u0 + 256, u2 = u0 + 512, u3 = u0 + 768; GMLP_DECL(a_); GMLP_DECL(b_);
                GMLP_LOAD(a_, Z, wsp, u0 >> 3, u0 & 7); GMLP_LOAD(b_, Z, wsp, u1 >> 3, u1 & 7);
                gmlp_unit((LAS unsigned char*)lds, Z, lng, lnb, bsp, a_uu, a_w, a_raw, u0 >> 3, u0 & 7, tid);
                GMLP_LOAD(a_, Z, wsp, u2 >> 3, u2 & 7);
                gmlp_unit((LAS unsigned char*)lds, Z, lng, lnb, bsp, b_uu, b_w, b_raw, u1 >> 3, u1 & 7, tid);
                GMLP_LOAD(b_, Z, wsp, u3 >> 3, u3 & 7);
                gmlp_unit((LAS unsigned char*)lds, Z, lng, lnb, bsp, a_uu, a_w, a_raw, u2 >> 3, u2 & 7, tid);
                gmlp_unit((LAS unsigned char*)lds, Z, lng, lnb, bsp, b_uu, b_w, b_raw, u3 >> 3, u3 & 7, tid);
            }
        } break;
#endif
#ifndef NO_ATTN
        case 2: {
            KARGS(A); bf16_t* Z = (bf16_t*)(A->ws + WS_Z); float* LSE = (float*)(A->ws + WS_LSE); const int G = gridDim.x;
            constexpr int TOTAL = NBATCH * 8 * 48;
            const bool xl8 = (G == 256); const int vcu = (blockIdx.x & 7) * 32 + (blockIdx.x >> 3);
#define ATT_ID(i) (xl8 ? ((vcu >> 3) * 48 + ((i) >> 1) * 16 + 2 * (vcu & 7) + ((i) & 1)) : ((int)blockIdx.x + (i) * G))
#define ATT_MORE(i) (xl8 ? (i) < 6 : ((int)blockIdx.x + (i) * G) < TOTAL)
            int i = 0;
            if (ATT_MORE(0)) {
                ABlock cur = attn_ref(ATT_ID(0), Z, LSE);
                swa::Seam<__hip_bfloat16> S;
                swa::causal_swa_prime<__hip_bfloat16, __hip_bfloat16>(cur, 129, (char*)lds, S);
                for (;;) {
                    const bool last = !ATT_MORE(i + 1);
                    const ABlock nxt = last ? cur : attn_ref(ATT_ID(i + 1), Z, LSE);
                    swa::causal_swa_block<__hip_bfloat16, __hip_bfloat16>(cur, nxt, SEQ, 129, (char*)lds, S);
                    if (last) break;
                    cur = nxt; ++i;
                }
            }
#undef ATT_ID
#undef ATT_MORE
        } break;
#endif
#ifndef NO_MERGE
        case 3: { PH_COMMON(); merge_rows((bf16_t*)(ws + WS_Z), (const float*)(ws + WS_LSE), A->in[9] + (size_t)l * 1024, A->in[10] + (size_t)l * 1024, gw, ngw, lane); } break;
#endif
#ifndef NO_G5
        case 4: {
            PH_COMMON();
            pg8::Gemm g{(const bf16_t*)(ws + WS_Z), (const bf16_t*)(ws + WS_W + (size_t)l * W_LAYER + W_OUT_OFF), M, DM, DM, INW}; pg8::StaticOrder S; S.init(M, DM, G, (int)blockIdx.x);
            pg8::EpiRes E{(bf16_t*)(ws + WS_XN), nullptr, DM, (float*)(ws + WS_RSQ) + (size_t)(l == 0 ? 1 : 3) * 8 * M, M, (LAS float*)((LAS unsigned char*)lds + XL_OFF)};
            pg8::gemm_phase<pg8::EpiRes, pg8::StaticOrder, true, true>((LAS unsigned char*)lds, g, S, E);
        } break;
#endif
#ifndef NO_G7
        case 5: {
            PH_COMMON();
            pg8::Gemm g{(const bf16_t*)(ws + WS_XN), (const bf16_t*)(ws + WS_W + (size_t)l * W_LAYER + W_GU_OFF), M, 2 * DFF, DM, DM}; pg8::StaticOrder S; S.init(M, 2 * DFF, G, (int)blockIdx.x);
            pg8::RowScale rsc{(const float*)(ws + WS_RSQ) + (size_t)(l == 0 ? 1 : 3) * 8 * M, 8, M, (LAS float*)((LAS unsigned char*)lds + RT_OFF)};
            pg8::EpiSwiGLU E{(bf16_t*)(ws + WS_Z), DFF, rsc};
            pg8::gemm_phase<pg8::EpiSwiGLU, pg8::StaticOrder, true, true>((LAS unsigned char*)lds, g, S, E);
        } break;
#endif
#ifndef NO_G8
        case 6: {
            PH_COMMON();
            pg8::Gemm g{(const bf16_t*)(ws + WS_Z), (const bf16_t*)(ws + WS_W + (size_t)l * W_LAYER + W_DN_OFF), M, DM, DFF, DFF}; pg8::StaticOrder S; S.init(M, DM, G, (int)blockIdx.x);
            pg8::EpiRes E{(bf16_t*)(ws + WS_XN), l == 0 ? (float*)nullptr : A->out, DM, l == 0 ? (float*)(ws + WS_RSQ) + (size_t)2 * 8 * M : (float*)nullptr, M, (LAS float*)((LAS unsigned char*)lds + XL_OFF)};
            pg8::gemm_phase<pg8::EpiRes, pg8::StaticOrder, true, true>((LAS unsigned char*)lds, g, S, E);
        } break;
#endif
        default: break;
        }
#if ONE_LAUNCH
        if (ph + 1 < ph_hi && s != 1) {
            if (ph_hi < 0) cg::this_grid().sync();
            { KARGS(Ab); XcdBarrier b; b.bar = (unsigned*)(Ab->ws + WS_CTL) + CW_BAR; b.x = xb_xcc_id(); b.st = (volatile LAS unsigned*)((LAS unsigned char*)lds + MISC_OFF) + 8; xcd_barrier(b); }
        }
#endif
    }
}

extern "C" void kernel_launch(void* const* d_in, const int* in_sizes, int n_in, void* d_out, int out_size, void* d_ws, size_t ws_size, hipStream_t stream) {
    static int grid = 0;
    if (grid == 0) {
        if (n_in != 16 || out_size != M * DM || ws_size < WS_END) { fprintf(stderr, "kernel_launch: unexpected shapes (n_in %d out %d ws %zu)\n", n_in, out_size, ws_size); grid = -1; return; }
        int dev = 0, cus = 0, per_cu = 0;
        (void)hipGetDevice(&dev); (void)hipDeviceGetAttribute(&cus, hipDeviceAttributeMultiprocessorCount, dev);
        if (hipFuncSetAttribute((const void*)fwd_kernel, hipFuncAttributeMaxDynamicSharedMemorySize, LDS_BYTES) != hipSuccess) fprintf(stderr, "kernel_launch: hipFuncSetAttribute failed\n");
        if (hipOccupancyMaxActiveBlocksPerMultiprocessor(&per_cu, (const void*)fwd_kernel, NWAVES * 64, LDS_BYTES) != hipSuccess || per_cu < 1) per_cu = 1;
        (void)hipGetLastError();
        if (cus <= 0) cus = 256;
        if (cus * per_cu < 256) { fprintf(stderr, "kernel_launch: needs 256 co-resident workgroups (have %d x %d)\n", cus, per_cu); grid = -1; return; }
        grid = 256;
    }
    if (grid < 0) return;
    (void)hipMemsetAsync((char*)d_ws + WS_CTL, 0, CTL_ZERO_BYTES, stream);
    Args a{};
    for (int i = 0; i < 16; ++i) a.in[i] = (const float*)d_in[i];
    a.out = (float*)d_out; a.ws = (unsigned char*)d_ws;
#if ONE_LAUNCH
    a.ph_lo = 0; a.ph_hi = NPASS * N_PHASES;
    void* kargs[] = {&a};
    hipError_t e = hipLaunchCooperativeKernel((const void*)fwd_kernel, dim3(grid), dim3(NWAVES * 64), kargs, LDS_BYTES, stream);
    if (e != hipSuccess) fprintf(stderr, "kernel_launch: cooperative launch failed: %s (grid %d)\n", hipGetErrorString(e), grid);
#else
    for (int ph = 0; ph < N_PHASES; ++ph) { a.ph_lo = ph; a.ph_hi = ph + 1; hipLaunchKernelGGL(fwd_kernel, dim3(grid), dim3(NWAVES * 64), LDS_BYTES, stream, a); }
#endif
}
```

```cpp
#include <hip/hip_runtime.h>
#include <hip/hip_bf16.h>
#include <hip/hip_cooperative_groups.h>
#include <cstdio>
#include <cstdint>
namespace cg = cooperative_groups;
__device__ __forceinline__ int ltid() { int t = threadIdx.x; asm volatile("" : "+v"(t)); return t; }
namespace pg8 {
#define PG8_LAS __attribute__((address_space(3)))
typedef unsigned short bf16_t;
typedef short bf16x8 __attribute__((ext_vector_type(8)));
typedef float f32x4 __attribute__((ext_vector_type(4)));
typedef unsigned u32x4 __attribute__((ext_vector_type(4)));
constexpr int BM = 256, BK = 64, HALF = 128, HTB = HALF * BK * 2  , STAGE_BYTES = 8 * HTB, NXCD = 8, WGM = 8;

__host__ __device__ __forceinline__ int lds_byte(int r, int c) { const int st = (r >> 4) * 2 + (c >> 5), rr = r & 15, cc = c & 31, ob = rr * 64 + cc * 2; return st * 1024 + (ob ^ (((ob >> 9) & 1) << 5)); }
__host__ __device__ __forceinline__ void stage_rc(int b, int& R, int& C) { const int st = b / 1024, sb = b % 1024, swz = sb ^ (((sb >> 9) & 1) << 5); R = (st >> 1) * 16 + swz / 64; C = (st & 1) * 32 + (swz % 64) / 2; }
__host__ __device__ __forceinline__ int perm32(int rho) { const int n = rho >> 4, i = rho & 15; return 8 * (i >> 2) + 4 * n + (i & 3); }

struct Unit { int pm, pn; };
struct Gemm { const bf16_t* A; const bf16_t* Bt; int M, N, K, lda; };

struct StaticOrder {
    int nM, nN, nwg, G, c;
    __host__ __device__ void init(int M, int N, int G_, int c_) { nM = M / BM; nN = N / BM; nwg = nM * nN; G = G_; c = c_; }
    __host__ __device__ bool next(int i, Unit& u) const {
        const long L = (long)i * G + c; if (L >= nwg) return false;
        int wgid = (int)L; { const int q = nwg / NXCD, r = nwg % NXCD, xcd = wgid % NXCD, off = wgid / NXCD; wgid = (xcd < r ? xcd * (q + 1) : r * (q + 1) + (xcd - r) * q) + off; }
        const int nig = WGM * nN, gid = wgid / nig, fm = gid * WGM, gsz = (nM - fm) < WGM ? (nM - fm) : WGM;
        u.pm = fm + ((wgid % nig) % gsz); u.pn = (wgid % nig) / gsz; return true;
    }
    __device__ __forceinline__ void a_ready(const Unit&) const {}
    __device__ __forceinline__ void done(const Unit&) const {}
};

__device__ __forceinline__ unsigned cvt_pk_bf16(float lo, float hi) { unsigned r; asm volatile("v_cvt_pk_bf16_f32 %0, %1, %2" : "=v"(r) : "v"(lo), "v"(hi)); return r; }
typedef float f32x2 __attribute__((ext_vector_type(2)));
__device__ __forceinline__ f32x2 gelu_pk(f32x2 v) {
    const f32x2 av = __builtin_elementwise_abs(v), d = av * 0.2316418882f + 1.0f;
    f32x2 t; t.x = __builtin_amdgcn_rcpf(d.x); t.y = __builtin_amdgcn_rcpf(d.y);
    f32x2 q = t * 0.5307027145f + (-0.7265760135f); q = q * t + 0.7107068705f; q = q * t + (-0.142248368f); q = q * t + 0.127414796f; q = q * t;
    const f32x2 s = (v * v) * (-0.72134752044f);
    f32x2 e; e.x = __builtin_amdgcn_exp2f(s.x); e.y = __builtin_amdgcn_exp2f(s.y);
    const f32x2 m = v * (q * e), r = v - m;
    f32x2 o; o.x = v.x < 0.f ? m.x : r.x; o.y = v.y < 0.f ? m.y : r.y; return o;
}
typedef unsigned u32x2 __attribute__((ext_vector_type(2)));
struct RowScale {
    const float* rsq; int nparts; int mtot; PG8_LAS float* tab;
    __device__ __forceinline__ int begin(const Unit& u) const {
        const int t = ltid();
        if (t < BM) { float v[8];
#pragma unroll
            for (int p = 0; p < 8; ++p) v[p] = rsq[(size_t)(p < nparts ? p : 0) * mtot + u.pm * BM + t];
            float s = v[0];
#pragma unroll
            for (int p = 1; p < 8; ++p) s += (p < nparts) ? v[p] : 0.f;
            tab[t] = s; }
        asm volatile("s_waitcnt lgkmcnt(0)\n\ts_barrier" ::: "memory");
        return u.pm;
    }
    __device__ __forceinline__ void preload(const Unit&, int, int wr, int fr, float (&pre)[8]) const {
#pragma unroll
        for (int i = 0; i < 8; ++i) pre[i] = tab[wr * 64 + fr + (i >> 2) * HALF + (i & 3) * 16];
    }
};
__device__ __forceinline__ float silu_f(float x) { return x * __builtin_amdgcn_rcpf(1.0f + __builtin_amdgcn_exp2f(-1.4426950408889634f * x)); }
struct EpiZ {
    static constexpr bool PERM = true, AFTER_DRAIN = false;
    bf16_t* O; int ldc; RowScale rsc; const float* qg; const float* kg; const float* rope; PG8_LAS float* xl;
    __device__ __forceinline__ int begin(const Unit& u) const { return rsc.begin(u); }
    __device__ __forceinline__ void preload(const Unit& u, int tab_pm, int wr, int fr, float (&pre)[8]) const { rsc.preload(u, tab_pm, wr, fr, pre); }
    __device__ __forceinline__ void operator()(const f32x4 (&acc)[2][2][4][2], const Unit& u, int wr, int wc, int fr, int fq, const float (&pre)[8]) const {
        const int row0 = u.pm * BM + wr * 64 + fr; const int col0 = u.pn * BM + wc * 32 + 8 * fq;
        if (u.pn >= 8 && u.pn < 24) {
            float rsv[2][4];
            u32x4 csv[2][4];
#pragma unroll
            for (int ai = 0; ai < 2; ++ai)
#pragma unroll
                for (int m = 0; m < 4; ++m) csv[ai][m] = *(const u32x4*)((const unsigned*)rope + (size_t)((row0 + ai * HALF + m * 16) & 4095) * 64 + 16 * wc + 4 * fq);
            asm volatile("" ::: "memory");
#pragma unroll
            for (int ai = 0; ai < 2; ++ai)
#pragma unroll
                for (int m = 0; m < 4; ++m) { const float rs = __builtin_amdgcn_rsqf(pre[ai * 4 + m] * (1.f / 2048.f) + 1e-6f); rsv[ai][m] = rs;
#pragma unroll
                    for (int bj = 0; bj < 2; ++bj) { const f32x4 a = acc[ai][bj][m][0] * rs, b = acc[ai][bj][m][1] * rs;
                        float ss = ((a[0] * a[0] + a[1] * a[1]) + (a[2] * a[2] + a[3] * a[3])) + ((b[0] * b[0] + b[1] * b[1]) + (b[2] * b[2] + b[3] * b[3]));
                        ss += __shfl_xor(ss, 16); ss += __shfl_xor(ss, 32);
                        if (fq == 0) xl[((ai * HALF + wr * 64 + m * 16 + fr) * 2 + bj) * 4 + wc] = ss; } }
            const float* gn = (u.pn < 20 ? qg : kg) + 16 * wc + 4 * fq;
            const f32x4 g1 = *(const f32x4*)gn, g2 = *(const f32x4*)(gn + 64);
            asm volatile("s_waitcnt lgkmcnt(0)\n\ts_barrier" ::: "memory");
#pragma unroll
            for (int ai = 0; ai < 2; ++ai)
#pragma unroll
                for (int m = 0; m < 4; ++m) { const int row = row0 + ai * HALF + m * 16; bf16_t* rowp = O + (size_t)row * ldc + col0; const float rs = rsv[ai][m];
                    const u32x4 cw = csv[ai][m]; const f32x4 cs = {__builtin_bit_cast(float, cw.x << 16), __builtin_bit_cast(float, cw.y << 16), __builtin_bit_cast(float, cw.z << 16), __builtin_bit_cast(float, cw.w << 16)},
                        sn = {__builtin_bit_cast(float, cw.x & 0xffff0000u), __builtin_bit_cast(float, cw.y & 0xffff0000u), __builtin_bit_cast(float, cw.z & 0xffff0000u), __builtin_bit_cast(float, cw.w & 0xffff0000u)};
#pragma unroll
                    for (int bj = 0; bj < 2; ++bj) { const f32x4 p = *(const PG8_LAS f32x4*)(xl + ((ai * HALF + wr * 64 + m * 16 + fr) * 2 + bj) * 4);
                        const float rh = rs * __builtin_amdgcn_rsqf(((p[0] + p[1]) + (p[2] + p[3])) * (1.f / 128.f) + 1e-6f);
                        const f32x4 y1 = acc[ai][bj][m][0] * rh * g1, y2 = acc[ai][bj][m][1] * rh * g2;
                        const f32x4 o1 = y1 * cs - y2 * sn, o2 = y2 * cs + y1 * sn;
                        u32x4 w; w.x = cvt_pk_bf16(o1[0], o1[1]); w.y = cvt_pk_bf16(o1[2], o1[3]); w.z = cvt_pk_bf16(o2[0], o2[1]); w.w = cvt_pk_bf16(o2[2], o2[3]);
                        *(u32x4*)(rowp + bj * HALF) = w; } }
            return;
        }
        const bool act = u.pn < 8;
#pragma unroll
        for (int ai = 0; ai < 2; ++ai)
#pragma unroll
            for (int m = 0; m < 4; ++m) { bf16_t* rowp = O + (size_t)(row0 + ai * HALF + m * 16) * ldc + col0;
                const float rs = __builtin_amdgcn_rsqf(pre[ai * 4 + m] * (1.f / 2048.f) + 1e-6f);
#pragma unroll
                for (int bj = 0; bj < 2; ++bj) { f32x4 v0 = acc[ai][bj][m][0] * rs, v1 = acc[ai][bj][m][1] * rs;
                    if (act) { f32x2 a = gelu_pk((f32x2){v0[0], v0[1]}), b = gelu_pk((f32x2){v0[2], v0[3]}), c = gelu_pk((f32x2){v1[0], v1[1]}), d = gelu_pk((f32x2){v1[2], v1[3]});
                        v0 = (f32x4){a.x, a.y, b.x, b.y}; v1 = (f32x4){c.x, c.y, d.x, d.y}; }
                    u32x4 w; w.x = cvt_pk_bf16(v0[0], v0[1]); w.y = cvt_pk_bf16(v0[2], v0[3]); w.z = cvt_pk_bf16(v1[0], v1[1]); w.w = cvt_pk_bf16(v1[2], v1[3]);
                    *(u32x4*)(rowp + bj * HALF) = w; } }
    }
};
struct EpiRes {
    static constexpr bool PERM = true, AFTER_DRAIN = false;
    bf16_t* xb; float* outf; int ldc; float* rsq_out; int mtot; PG8_LAS float* xl;
    __device__ __forceinline__ int begin(const Unit& u) const { return u.pm; }
    __device__ __forceinline__ void preload(const Unit&, int, int, int, float (&pre)[8]) const {
#pragma unroll
        for (int i = 0; i < 8; ++i) pre[i] = 0.f;
    }
    __device__ __forceinline__ void operator()(const f32x4 (&acc)[2][2][4][2], const Unit& u, int wr, int wc, int fr, int fq, const float (&)[8]) const {
        const int col0 = u.pn * BM + wc * 32 + 8 * fq;
        u32x4 bx[2][4][2];
#pragma unroll
        for (int ai = 0; ai < 2; ++ai)
#pragma unroll
            for (int m = 0; m < 4; ++m)
#pragma unroll
                for (int bj = 0; bj < 2; ++bj) bx[ai][m][bj] = *(const u32x4*)(xb + (size_t)(u.pm * BM + ai * HALF + wr * 64 + m * 16 + fr) * ldc + col0 + bj * HALF);
        asm volatile("" ::: "memory");
#pragma unroll
        for (int ai = 0; ai < 2; ++ai)
#pragma unroll
            for (int m = 0; m < 4; ++m) { const int rl = ai * HALF + wr * 64 + m * 16 + fr; const size_t off = (size_t)(u.pm * BM + rl) * ldc + col0;
                float ss = 0.f;
#pragma unroll
                for (int bj = 0; bj < 2; ++bj) { const u32x4 b = bx[ai][m][bj];
                    f32x4 o0, o1;
                    o0[0] = __builtin_bit_cast(float, b.x << 16) + acc[ai][bj][m][0][0]; o0[1] = __builtin_bit_cast(float, b.x & 0xffff0000u) + acc[ai][bj][m][0][1];
                    o0[2] = __builtin_bit_cast(float, b.y << 16) + acc[ai][bj][m][0][2]; o0[3] = __builtin_bit_cast(float, b.y & 0xffff0000u) + acc[ai][bj][m][0][3];
                    o1[0] = __builtin_bit_cast(float, b.z << 16) + acc[ai][bj][m][1][0]; o1[1] = __builtin_bit_cast(float, b.z & 0xffff0000u) + acc[ai][bj][m][1][1];
                    o1[2] = __builtin_bit_cast(float, b.w << 16) + acc[ai][bj][m][1][2]; o1[3] = __builtin_bit_cast(float, b.w & 0xffff0000u) + acc[ai][bj][m][1][3];
                    if (outf) { *(f32x4*)(outf + off + bj * HALF) = o0; *(f32x4*)(outf + off + bj * HALF + 4) = o1; }
                    else { ss += ((o0[0] * o0[0] + o0[1] * o0[1]) + (o0[2] * o0[2] + o0[3] * o0[3])) + ((o1[0] * o1[0] + o1[1] * o1[1]) + (o1[2] * o1[2] + o1[3] * o1[3]));
                        u32x4 w; w.x = cvt_pk_bf16(o0[0], o0[1]); w.y = cvt_pk_bf16(o0[2], o0[3]); w.z = cvt_pk_bf16(o1[0], o1[1]); w.w = cvt_pk_bf16(o1[2], o1[3]); *(u32x4*)(xb + off + bj * HALF) = w; } }
                if (rsq_out) { ss += __shfl_xor(ss, 16); ss += __shfl_xor(ss, 32); if (fq == 0) xl[rl * 4 + wc] = ss; } }
        if (rsq_out) {
            asm volatile("s_waitcnt lgkmcnt(0)\n\ts_barrier" ::: "memory");
            const int t = ltid();
            if (t < BM) { const f32x4 p = *(const PG8_LAS f32x4*)(xl + 4 * t); rsq_out[(size_t)u.pn * mtot + u.pm * BM + t] = (p[0] + p[1]) + (p[2] + p[3]); }
        }
    }
};
struct EpiSwiGLU {
    static constexpr bool PERM = true, AFTER_DRAIN = false;
    bf16_t* O; int ldc; RowScale rsc;
    __device__ __forceinline__ int begin(const Unit& u) const { return rsc.begin(u); }
    __device__ __forceinline__ void preload(const Unit& u, int tab_pm, int wr, int fr, float (&pre)[8]) const { rsc.preload(u, tab_pm, wr, fr, pre); }
    __device__ __forceinline__ void operator()(const f32x4 (&acc)[2][2][4][2], const Unit& u, int wr, int wc, int fr, int fq, const float (&pre)[8]) const {
        const int row0 = u.pm * BM + wr * 64 + fr; const int col0 = u.pn * HALF + wc * 32 + 8 * fq;
#pragma unroll
        for (int ai = 0; ai < 2; ++ai)
#pragma unroll
            for (int m = 0; m < 4; ++m) { bf16_t* rowp = O + (size_t)(row0 + ai * HALF + m * 16) * ldc + col0;
                const float rs = __builtin_amdgcn_rsqf(pre[ai * 4 + m] * (1.f / 2048.f) + 1e-6f);
                const f32x4 g0 = acc[ai][0][m][0] * rs, g1 = acc[ai][0][m][1] * rs, u0 = acc[ai][1][m][0] * rs, u1 = acc[ai][1][m][1] * rs;
                u32x4 w; w.x = cvt_pk_bf16(silu_f(g0[0]) * u0[0], silu_f(g0[1]) * u0[1]); w.y = cvt_pk_bf16(silu_f(g0[2]) * u0[2], silu_f(g0[3]) * u0[3]);
                w.z = cvt_pk_bf16(silu_f(g1[0]) * u1[0], silu_f(g1[1]) * u1[1]); w.w = cvt_pk_bf16(silu_f(g1[2]) * u1[2], silu_f(g1[3]) * u1[3]);
                *(u32x4*)rowp = w; }
    }
};
template <class Epi, class Sched, bool ALIGN_EPI = false, bool SP2 = false>
__device__ __forceinline__ void gemm_phase(PG8_LAS unsigned char* lds, const Gemm g, const Sched& S, const Epi& E) {
    const int tid = ltid(), wid = __builtin_amdgcn_readfirstlane(tid >> 6), lane = tid & 63, wr = wid >> 2, wc = wid & 3, fr = lane & 15, fq = lane >> 4;
    const int K = g.K, nt = K / BK;
    unsigned voffA[2], voffB[2];
#pragma unroll
    for (int i = 0; i < 2; ++i) { int R, C; stage_rc(tid * 16 + i * 8192, R, C); const int Rb = Epi::PERM ? ((R & ~31) + perm32(R & 31)) : R;
        voffA[i] = (unsigned)(R * g.lda + C) * 2u; voffB[i] = (unsigned)(Rb * K + C) * 2u; }
    const size_t kstep = (size_t)(BK * 2);
    const size_t hstep = (size_t)HALF * K * 2;
    const size_t tstep = 2 * hstep;
    const size_t hstepA = (size_t)HALF * g.lda * 2, tstepA = 2 * hstepA;
    const unsigned ldsw = (unsigned)wid * 1024u;
    const int aoff = lds_byte(wr * 64 + fr, fq * 8), boff = lds_byte(wc * 32 + fr, fq * 8);
#define PG8_SA(b, h) (((b) * 2 + (h)) * HTB)
#define PG8_SB(b, h) ((4 + (b) * 2 + (h)) * HTB)
#define PG8_STAGE(bufoff, gbase, voff) do { _Pragma("unroll") for (int _i = 0; _i < 2; ++_i) \
        __builtin_amdgcn_global_load_lds((const unsigned*)((const char*)(gbase) + (voff)[_i]), (PG8_LAS unsigned*)(lds + (bufoff) + ldsw + _i * 8192), 16, 0, 0); } while (0)
#define PG8_LDA(dst, b, h) do { _Pragma("unroll") for (int m = 0; m < 4; ++m) _Pragma("unroll") for (int k = 0; k < 2; ++k) dst[m][k] = *(const PG8_LAS bf16x8*)(lds + PG8_SA(b, h) + aoff + m * 2048 + k * 1024); } while (0)
#define PG8_LDB(dst, b, h) do { _Pragma("unroll") for (int n = 0; n < 2; ++n) _Pragma("unroll") for (int k = 0; k < 2; ++k) dst[n][k] = *(const PG8_LAS bf16x8*)(lds + PG8_SB(b, h) + boff + n * 2048 + k * 1024); } while (0)
#define PG8_MMA(ai, bj, At, Bt) do { __builtin_amdgcn_s_setprio(1); _Pragma("unroll") for (int m = 0; m < 4; ++m) _Pragma("unroll") for (int n = 0; n < 2; ++n) _Pragma("unroll") for (int k = 0; k < 2; ++k) \
        acc[ai][bj][m][n] = __builtin_amdgcn_mfma_f32_16x16x32_bf16(Bt[n][k], At[m][k], acc[ai][bj][m][n], 0, 0, 0); __builtin_amdgcn_s_setprio(0); } while (0)
#define PG8_WAIT_V(n) asm volatile("s_waitcnt vmcnt(" #n ")" ::: "memory")
#define PG8_WAIT_L(n) asm volatile("s_waitcnt lgkmcnt(" #n ")" ::: "memory")
#define PG8_BAR __builtin_amdgcn_s_barrier()
#define PG8_SCHED __builtin_amdgcn_sched_barrier(0)
    Unit cur, nxt; int ui = 0;
    if (!S.next(0, cur)) return;
    float pre[8], preN[8];
    const int tab_pm = E.begin(cur);
    E.preload(cur, tab_pm, wr, fr, pre);
    f32x4 acc[2][2][4][2];
#pragma unroll
    for (int a = 0; a < 2; ++a)
#pragma unroll
        for (int b = 0; b < 2; ++b)
#pragma unroll
            for (int m = 0; m < 4; ++m)
#pragma unroll
                for (int n = 0; n < 2; ++n) acc[a][b][m][n] = (f32x4){0.f, 0.f, 0.f, 0.f};
    bf16x8 At[4][2], B0[2][2], B1[2][2];
    const char* cA = (const char*)g.A + (size_t)cur.pm * tstepA; const char* cB = (const char*)g.Bt + (size_t)cur.pn * tstep;
    S.a_ready(cur);
    if constexpr (SP2) {
        PG8_STAGE(PG8_SB(0, 0), cB, voffB); PG8_STAGE(PG8_SB(0, 1), cB + hstep, voffB); PG8_STAGE(PG8_SA(0, 0), cA, voffA); PG8_STAGE(PG8_SA(0, 1), cA + hstepA, voffA);
        if (wr == 1) PG8_BAR;
        PG8_WAIT_V(2); PG8_BAR;
        PG8_STAGE(PG8_SB(1, 0), cB + kstep, voffB); PG8_STAGE(PG8_SA(1, 0), cA + kstep, voffA); PG8_STAGE(PG8_SB(1, 1), cB + hstep + kstep, voffB);
        PG8_WAIT_V(6); PG8_BAR;
    } else {
        PG8_STAGE(PG8_SB(0, 0), cB, voffB); PG8_STAGE(PG8_SA(0, 0), cA, voffA); PG8_STAGE(PG8_SB(0, 1), cB + hstep, voffB); PG8_STAGE(PG8_SA(0, 1), cA + hstepA, voffA);
        if (wr == 1) PG8_BAR;
        PG8_WAIT_V(4); PG8_BAR;
        PG8_STAGE(PG8_SB(1, 0), cB + kstep, voffB); PG8_STAGE(PG8_SA(1, 0), cA + kstep, voffA); PG8_STAGE(PG8_SB(1, 1), cB + hstep + kstep, voffB);
        PG8_WAIT_V(6); PG8_BAR;
    }
    for (;;) {
        const bool has_next = S.next(ui + 1, nxt);
        const char* nA = has_next ? (const char*)g.A + (size_t)nxt.pm * tstepA : cA; const char* nB = has_next ? (const char*)g.Bt + (size_t)nxt.pn * tstep : cB;
        for (int t = 0; t < nt; t += 2) {
            const bool last = (t == nt - 2);
            const char* a1 = cA + (size_t)(t + 1) * kstep;
            const char* a2 = last ? nA : cA + (size_t)(t + 2) * kstep; const char* b2 = last ? nB : cB + (size_t)(t + 2) * kstep;
            const char* a3 = a2 + kstep; const char* b3 = b2 + kstep;
            if (last && has_next) S.a_ready(nxt);
            if constexpr (SP2) {
            PG8_LDB(B0, 0, 0); PG8_LDB(B1, 0, 1); PG8_SCHED; PG8_LDA(At, 0, 0); PG8_STAGE(PG8_SA(1, 1), a1 + hstepA, voffA);
            PG8_WAIT_V(8); PG8_WAIT_L(0); PG8_BAR; PG8_MMA(0, 0, At, B0); PG8_MMA(0, 1, At, B1); PG8_BAR; PG8_SCHED;
            PG8_LDA(At, 0, 1); PG8_STAGE(PG8_SB(0, 0), b2, voffB); PG8_STAGE(PG8_SB(0, 1), b2 + hstep, voffB); PG8_STAGE(PG8_SA(0, 0), a2, voffA);
            PG8_WAIT_V(8); PG8_WAIT_L(0); PG8_BAR; PG8_MMA(1, 0, At, B0); PG8_MMA(1, 1, At, B1); PG8_BAR; PG8_SCHED;
            PG8_LDB(B0, 1, 0); PG8_LDB(B1, 1, 1); PG8_SCHED; PG8_LDA(At, 1, 0); PG8_STAGE(PG8_SA(0, 1), a2 + hstepA, voffA);
            PG8_WAIT_V(8); PG8_WAIT_L(0); PG8_BAR; PG8_MMA(0, 0, At, B0); PG8_MMA(0, 1, At, B1); PG8_BAR; PG8_SCHED;
            PG8_LDA(At, 1, 1); PG8_STAGE(PG8_SB(1, 0), b3, voffB); PG8_STAGE(PG8_SB(1, 1), b3 + hstep, voffB); PG8_STAGE(PG8_SA(1, 0), a3, voffA);
            PG8_WAIT_V(8); PG8_WAIT_L(0); PG8_BAR; PG8_MMA(1, 0, At, B0); PG8_MMA(1, 1, At, B1); PG8_BAR; PG8_SCHED;
            } else {
            PG8_LDB(B0, 0, 0); PG8_SCHED; PG8_LDA(At, 0, 0); PG8_STAGE(PG8_SA(1, 1), a1 + hstepA, voffA);
            PG8_WAIT_L(8); PG8_BAR; PG8_WAIT_L(0); PG8_MMA(0, 0, At, B0); PG8_BAR; PG8_SCHED;
            PG8_LDB(B1, 0, 1); PG8_STAGE(PG8_SB(0, 0), b2, voffB);
            PG8_BAR; PG8_WAIT_L(0); PG8_MMA(0, 1, At, B1); PG8_BAR;
            PG8_LDA(At, 0, 1); PG8_STAGE(PG8_SA(0, 0), a2, voffA);
            PG8_BAR; PG8_WAIT_L(0); PG8_MMA(1, 0, At, B0); PG8_BAR; PG8_SCHED;
            PG8_STAGE(PG8_SB(0, 1), b2 + hstep, voffB);
            PG8_WAIT_V(6); PG8_BAR; PG8_MMA(1, 1, At, B1); PG8_BAR;
            PG8_LDB(B0, 1, 0); PG8_SCHED; PG8_LDA(At, 1, 0); PG8_STAGE(PG8_SA(0, 1), a2 + hstepA, voffA);
            PG8_WAIT_L(8); PG8_BAR; PG8_WAIT_L(0); PG8_MMA(0, 0, At, B0); PG8_BAR; PG8_SCHED;
            PG8_LDB(B1, 1, 1); PG8_STAGE(PG8_SB(1, 0), b3, voffB);
            PG8_BAR; PG8_WAIT_L(0); PG8_MMA(0, 1, At, B1); PG8_BAR;
            PG8_LDA(At, 1, 1); PG8_STAGE(PG8_SA(1, 0), a3, voffA);
            PG8_BAR; PG8_WAIT_L(0); PG8_MMA(1, 0, At, B0); PG8_BAR; PG8_SCHED;
            PG8_STAGE(PG8_SB(1, 1), b3 + hstep, voffB);
            PG8_WAIT_V(6); PG8_BAR; PG8_MMA(1, 1, At, B1); PG8_BAR;
            }
        }
        if constexpr (ALIGN_EPI) { if (wr == 0) PG8_BAR; }
        if (has_next) E.preload(nxt, tab_pm, wr, fr, preN);
        if constexpr (!Epi::AFTER_DRAIN) { E(acc, cur, wr, wc, fr, fq, pre); S.done(cur); }
#pragma unroll
        for (int i_ = 0; i_ < 8; ++i_) pre[i_] = preN[i_];
        if (!has_next) break;
#pragma unroll
        for (int a = 0; a < 2; ++a)
#pragma unroll
            for (int b = 0; b < 2; ++b)
#pragma unroll
                for (int m = 0; m < 4; ++m)
#pragma unroll
                    for (int n = 0; n < 2; ++n) acc[a][b][m][n] = (f32x4){0.f, 0.f, 0.f, 0.f};
        cur = nxt; cA = nA; cB = nB; ++ui;
        if constexpr (ALIGN_EPI) { if (wr == 1) PG8_BAR; }
    }
    PG8_WAIT_V(0);
    if constexpr (!ALIGN_EPI) { if (wr == 0) PG8_BAR; }
    PG8_BAR;
    if constexpr (Epi::AFTER_DRAIN) { E.fused(acc, cur, wr, wc, fr, fq, lds, wid, lane); S.done(cur); }
#undef PG8_SA
#undef PG8_SB
#undef PG8_STAGE
#undef PG8_LDA
#undef PG8_LDB
#undef PG8_MMA
#undef PG8_WAIT_V
#undef PG8_WAIT_L
#undef PG8_BAR
#undef PG8_SCHED
}
}
namespace swa {
constexpr int D = 128;
constexpr float THR = 8.f;
constexpr bool WSKIP = true;
constexpr float SCALE = 0.08838834764831845f;
constexpr int NW = 8, QBLK = 32, KVBLK = 64, QB = NW * QBLK;
constexpr int SHM_V = KVBLK * D * 2, SHM_K = KVBLK * D * 2;
constexpr int LDS_BYTES = 2 * SHM_V + 2 * SHM_K + NW * 64 * 4;
using bf16 = __hip_bfloat16;
typedef short bf16x8 __attribute__((ext_vector_type(8)));
typedef short s16x4 __attribute__((ext_vector_type(4)));
typedef float f32x16 __attribute__((ext_vector_type(16)));
typedef float f32x4 __attribute__((ext_vector_type(4)));
typedef unsigned u32x4 __attribute__((ext_vector_type(4)));
template <class A, class Bt> struct same_t { static constexpr bool v = false; };
template <class A> struct same_t<A, A> { static constexpr bool v = true; };

#define KSWZ(row, colB) ((row) * 256 + ((colB) ^ (((row) & 7) << 4)))
#define SBAR() __builtin_amdgcn_sched_barrier(0)
__device__ __forceinline__ int v_st(int k, int c) { const int kk = (k & ~0xC) | ((k & 4) << 1) | ((k & 8) >> 1); return ((kk >> 3) * 4 + (c >> 5)) * 512 + ((kk & 7) * 32 + (c & 31)) * 2; }
__device__ __forceinline__ int v_rd_base(int lane) { return ((lane & 3) << 3) | (((lane >> 2) & 3) << 6) | (((lane >> 4) & 1) << 5) | (((lane >> 5) & 1) << 8); }
constexpr int v_rd_off(int d0, int ks, int half) { return d0 * 512 + ks * 4096 + half * 2048; }
__device__ __forceinline__ int crow(int r, int hi) { return (r & 3) + 8 * (r >> 2) + 4 * hi; }
__device__ __forceinline__ unsigned cvtpk(float lo, float hi) {
    unsigned r; asm volatile("v_cvt_pk_bf16_f32 %0, %1, %2" : "=v"(r) : "v"(lo), "v"(hi)); return r;
}
__device__ __forceinline__ bf16x8 pack8(f32x4 a, f32x4 b) {
    u32x4 w = {cvtpk(a[0], a[1]), cvtpk(a[2], a[3]), cvtpk(b[0], b[1]), cvtpk(b[2], b[3])};
    return *reinterpret_cast<bf16x8*>(&w);
}
template <class T> __device__ __forceinline__ bf16x8 load8(const T* p) {
    if constexpr (same_t<T, float>::v) { return pack8(*(const f32x4*)p, *(const f32x4*)(p + 4)); }
    else { return *reinterpret_cast<const bf16x8*>(p); }
}
__device__ __forceinline__ void mask_tile(f32x16& p0, f32x16& p1, int dq, unsigned W) {
    const float NEG = -__builtin_inff();
#pragma unroll
    for (int r = 0; r < 16; ++r) {
        const int c = (r & 3) + 8 * (r >> 2);
        if ((unsigned)(dq - c) >= W) p0[r] = NEG;
        if ((unsigned)(dq - c - 32) >= W) p1[r] = NEG;
    }
}
__device__ __forceinline__ void partialSM(f32x16& p0, f32x16& p1, float& m_reg, float& mn, float& alpha) {
    float pmax = p0[0]; for (int r = 1; r < 16; ++r) pmax = fmaxf(pmax, p0[r]); for (int r = 0; r < 16; ++r) pmax = fmaxf(pmax, p1[r]);
    { auto rr = __builtin_amdgcn_permlane32_swap(__float_as_uint(pmax), __float_as_uint(pmax), false, false);
      pmax = fmaxf(__uint_as_float(rr[0]), __uint_as_float(rr[1])); }
    constexpr float C2 = 1.4426950408889634f * SCALE;
    if (__builtin_expect(__all((pmax - m_reg) * SCALE <= THR), 1)) { mn = m_reg; alpha = 1.f; }
    else { mn = fmaxf(m_reg, pmax); alpha = __builtin_amdgcn_exp2f((m_reg - mn) * C2); m_reg = mn; }
    const float mnL = -mn * C2;
    for (int r = 0; r < 16; ++r) p0[r] = fmaf(p0[r], C2, mnL); for (int r = 0; r < 16; ++r) p1[r] = fmaf(p1[r], C2, mnL);
    for (int r = 0; r < 16; ++r) p0[r] = __builtin_amdgcn_exp2f(p0[r]);
}
__device__ __forceinline__ void finishSM(f32x16& p0, f32x16& p1, float alpha, float& l_reg, bf16x8& pa0, bf16x8& pa1, bf16x8& pa2, bf16x8& pa3) {
    for (int r = 0; r < 16; ++r) p1[r] = __builtin_amdgcn_exp2f(p1[r]);
    float ps = 0; for (int r = 0; r < 16; ++r) ps += p0[r]; for (int r = 0; r < 16; ++r) ps += p1[r];
    { auto rr = __builtin_amdgcn_permlane32_swap(__float_as_uint(ps), __float_as_uint(ps), false, false);
      ps = __uint_as_float(rr[0]) + __uint_as_float(rr[1]); }
    l_reg = l_reg * alpha + ps;
#define PK4(P, B_, OUT) do { unsigned a0 = cvtpk(P[B_+0], P[B_+1]), a1 = cvtpk(P[B_+2], P[B_+3]);                          \
        unsigned b0 = cvtpk(P[B_+4], P[B_+5]), b1 = cvtpk(P[B_+6], P[B_+7]);                                             \
        auto r0 = __builtin_amdgcn_permlane32_swap(a0, b0, false, false); auto r1 = __builtin_amdgcn_permlane32_swap(a1, b1, false, false); \
        u32x4 w = {r0[0], r1[0], r0[1], r1[1]}; OUT = *reinterpret_cast<bf16x8*>(&w); } while (0)
    PK4(p0, 0, pa0); PK4(p0, 8, pa1); PK4(p1, 0, pa2); PK4(p1, 8, pa3);
#undef PK4
}
template <int KB, bool SK>
__device__ __forceinline__ void qkt(f32x16& p0, f32x16& p1, const char* K_lds, int r32, int hi, const bf16x8* qr, bool act) {
    if (SK && !act) { const float NEG = -__builtin_inff();
#pragma unroll
        for (int r = 0; r < 16; ++r) { p0[r] = NEG; p1[r] = NEG; } return; }
    p0 = f32x16{}; p1 = f32x16{};
    const char* kb[4];
#pragma unroll
    for (int dd = 0; dd < 4; ++dd) kb[dd] = K_lds + KB * SHM_K + KSWZ(r32, (dd * 16 + hi * 8) * 2);
#pragma unroll
    for (int d0 = 0; d0 < 8; ++d0) { const char* a = kb[d0 & 3] + (d0 >> 2) * 128;
        bf16x8 b0 = *reinterpret_cast<const bf16x8*>(a);
        bf16x8 b1 = *reinterpret_cast<const bf16x8*>(a + 32 * 256);
        p0 = __builtin_amdgcn_mfma_f32_32x32x16_bf16(b0, qr[d0], p0, 0, 0, 0);
        p1 = __builtin_amdgcn_mfma_f32_32x32x16_bf16(b1, qr[d0], p1, 0, 0, 0); }
}
template <int VB, bool SK>
__device__ __forceinline__ void pv_tile(f32x16* o, int vb0, bf16x8 pa0, bf16x8 pa1, bf16x8 pa2, bf16x8 pa3, bool act) {
    if (SK && !act) return;
#define TRRD(dst, off) asm volatile("ds_read_b64_tr_b16 %0, %1 offset:%2" : "=&v"(dst) : "v"(vb0), "i"(off) : "memory")
#define PV_D0(d0) do { s16x4 l0, l1, l2, l3, h0, h1, h2, h3; constexpr int b_ = VB * SHM_V + v_rd_off(d0, 0, 0);     \
        TRRD(l0, b_); TRRD(h0, b_ + 2048); TRRD(l1, b_ + 4096); TRRD(h1, b_ + 6144); TRRD(l2, b_ + 8192); TRRD(h2, b_ + 10240); TRRD(l3, b_ + 12288); TRRD(h3, b_ + 14336); \
        asm volatile("s_waitcnt lgkmcnt(0)" ::: "memory"); SBAR();                 \
        o[d0] = __builtin_amdgcn_mfma_f32_32x32x16_bf16(pa0, (bf16x8){l0[0], l0[1], l0[2], l0[3], h0[0], h0[1], h0[2], h0[3]}, o[d0], 0, 0, 0);   \
        o[d0] = __builtin_amdgcn_mfma_f32_32x32x16_bf16(pa1, (bf16x8){l1[0], l1[1], l1[2], l1[3], h1[0], h1[1], h1[2], h1[3]}, o[d0], 0, 0, 0);   \
        o[d0] = __builtin_amdgcn_mfma_f32_32x32x16_bf16(pa2, (bf16x8){l2[0], l2[1], l2[2], l2[3], h2[0], h2[1], h2[2], h2[3]}, o[d0], 0, 0, 0);   \
        o[d0] = __builtin_amdgcn_mfma_f32_32x32x16_bf16(pa3, (bf16x8){l3[0], l3[1], l3[2], l3[3], h3[0], h3[1], h3[2], h3[3]}, o[d0], 0, 0, 0); } while (0)
    PV_D0(0); PV_D0(1); PV_D0(2); PV_D0(3);
#undef PV_D0
#undef TRRD
}

template <class TIn, class TOut> struct BlockRef { const TIn* Q; const TIn* K; const TIn* V; TOut* O; float* L; int P0; int pitch; int lpitch; };
template <class TIn> struct Seam {
    bf16x8 qr[8];
    bf16x8 st_v0, st_v1, st_k0, st_k1; f32x4 sf0, sf1, sf2, sf3;
    f32x4 tq[16];
};
__device__ __forceinline__ int swa_jlo(int P0, int W) { const int lowk = P0 - W + 1; return lowk > 0 ? lowk / KVBLK : 0; }
#define ROWP(p, k0, rr, pt) ((p) + (size_t)((k0) + (rr)) * (size_t)(pt) + sc)
#define ROW(p, k0, rr) ROWP(p, k0, rr, rowp_)
#define VMW() asm volatile("s_waitcnt vmcnt(0)" ::: "memory")
#define VMWN(n) asm volatile("s_waitcnt vmcnt(%0)" :: "i"(n) : "memory")
#define SLOAD_HP(Kp, Vp, k0, pt) do { S.st_v0 = load8<TIn>(ROWP(Vp, k0, sr, pt)); S.st_v1 = load8<TIn>(ROWP(Vp, k0, 32 + sr, pt));              \
                         S.st_k0 = load8<TIn>(ROWP(Kp, k0, sr, pt)); S.st_k1 = load8<TIn>(ROWP(Kp, k0, 32 + sr, pt)); } while (0)
#define SLOAD_H(Kp, Vp, k0) SLOAD_HP(Kp, Vp, k0, rowp_)
#define SWRITE_HK(bf) do { *(bf16x8*)(K_lds + (bf) * SHM_K + kws) = S.st_k0; *(bf16x8*)(K_lds + (bf) * SHM_K + kws + 32 * 256) = S.st_k1; } while (0)
#define SWRITE_HV(bf) do { *(bf16x8*)(V_lds + (bf) * SHM_V + vst0) = S.st_v0; *(bf16x8*)(V_lds + (bf) * SHM_V + vst1) = S.st_v1; } while (0)
#define SWRITE_H(bf) do { SWRITE_HV(bf); SWRITE_HK(bf); } while (0)
#define SLOAD_F(p, k0) do { S.sf0 = *(const f32x4*)ROW(p, k0, sr); S.sf1 = *(const f32x4*)(ROW(p, k0, sr) + 4);                \
                            S.sf2 = *(const f32x4*)ROW(p, k0, 32 + sr); S.sf3 = *(const f32x4*)(ROW(p, k0, 32 + sr) + 4); } while (0)
#define SWRITE_KF(bf) do { *(bf16x8*)(K_lds + (bf) * SHM_K + kws) = pack8(S.sf0, S.sf1); *(bf16x8*)(K_lds + (bf) * SHM_K + kws + 32 * 256) = pack8(S.sf2, S.sf3); } while (0)
#define SWRITE_VF(bf) do { *(bf16x8*)(V_lds + (bf) * SHM_V + vst0) = pack8(S.sf0, S.sf1); *(bf16x8*)(V_lds + (bf) * SHM_V + vst1) = pack8(S.sf2, S.sf3); } while (0)
template <class TIn, class TOut>
__device__ __forceinline__ void causal_swa_prime(const BlockRef<TIn, TOut>& cur, int W, char* lds, Seam<TIn>& S) {
    constexpr bool F32 = same_t<TIn, float>::v;
    const int tid = ltid(), wid = __builtin_amdgcn_readfirstlane(tid >> 6), lane = tid & 63, r32 = lane & 31, hi = lane >> 5;
    const int sr = tid >> 4, sc = (tid & 15) * 8, kws = KSWZ(sr, sc * 2); char* K_lds = lds + 2 * SHM_V;
    const int kb0 = swa_jlo(cur.P0, W) * KVBLK; const int rowp_ = cur.pitch;
    for (int d0 = 0; d0 < 8; ++d0) S.qr[d0] = load8<TIn>(cur.Q + (size_t)(wid * QBLK + r32) * (size_t)cur.pitch + d0 * 16 + hi * 8);
    if constexpr (F32) { SLOAD_F((const float*)cur.K, kb0); VMW(); SWRITE_KF(0); SBAR(); SLOAD_F((const float*)cur.V, kb0); }
    else { SLOAD_H(cur.K, cur.V, kb0); VMW(); SWRITE_HK(0); }
    __syncthreads();
}
template <class TIn, class TOut>
__device__ __forceinline__ void causal_swa_block(const BlockRef<TIn, TOut>& cur, const BlockRef<TIn, TOut>& nxt, int skv, int W, char* lds, Seam<TIn>& S) {
    constexpr bool F32 = same_t<TIn, float>::v;
    const int tid = ltid(), wid = __builtin_amdgcn_readfirstlane(tid >> 6), lane = tid & 63, r32 = lane & 31, hi = lane >> 5;
    const int j_lo = swa_jlo(cur.P0, W); const int rowp_ = cur.pitch;
    int j_hi = (cur.P0 + QB - 1) / KVBLK + 1; if (j_hi > skv / KVBLK) j_hi = skv / KVBLK;
    const int NT = j_hi - j_lo;
    const int kbn = swa_jlo(nxt.P0, W) * KVBLK;
    const int qlo = cur.P0 + wid * QBLK, qm = qlo + r32 - 4 * hi;
    char* V_lds = lds; char* K_lds = lds + 2 * SHM_V;
    float* ws = (float*)(lds + 2 * SHM_V + 2 * SHM_K) + wid * 64; float* li_l = ws, * al_l = ws + 32;
    float m_reg = -1e30f, l_reg = 0; f32x16 o[4] = {};
    const int sr = tid >> 4, sc = (tid & 15) * 8, vst0 = v_st(sr, sc), vst1 = v_st(32 + sr, sc), kws = KSWZ(sr, sc * 2);
    const int vb0 = (int)(uintptr_t)V_lds + v_rd_base(lane);
    const TIn* Kh = cur.K; const TIn* Vh = cur.V;
#define RESC(a) do { if (__any((a) < 1.f)) { if (hi == 0) al_l[r32] = (a); asm volatile("s_waitcnt lgkmcnt(0)" ::: "memory");              \
                     for (int d_ = 0; d_ < 4; ++d_) for (int r = 0; r < 16; ++r) o[d_][r] *= al_l[crow(r, hi)]; } } while (0)
#define KBASE(t) ((j_lo + (t)) * KVBLK)
#define ACT(t) (KBASE(t) <= qlo + QBLK - 1 && KBASE(t) + KVBLK - 1 >= qlo - W + 1)
#define MASKT(P0_, P1_, t) do { const int kb_ = KBASE(t); if ((!SK || ACT(t)) && (kb_ + KVBLK - 1 > qlo || kb_ <= qlo + QBLK - 1 - W)) mask_tile(P0_, P1_, qm - kb_, (unsigned)W); } while (0)
    constexpr int NQL = F32 ? 16 : 8;
    constexpr bool SK = WSKIP && !F32;
#define SEAM_K0() do { VMWN(NQL); if constexpr (F32) { SWRITE_KF(0); SBAR(); SLOAD_F((const float*)nxt.V, kbn); } else { SWRITE_HK(0); } SBAR(); } while (0)
    f32x16 pA0, pA1, pB0, pB1; float mnA, mnB, alA, alB; bf16x8 pa0, pa1, pa2, pa3;
    if constexpr (F32) { VMW(); SWRITE_VF(0); SBAR(); } else { SWRITE_HV(0); SBAR(); }
    if (NT > 1) { if constexpr (F32) SLOAD_F((const float*)Kh, KBASE(1)); else SLOAD_H(Kh, Vh, KBASE(1)); }
    SBAR(); qkt<0, SK>(pA0, pA1, K_lds, r32, hi, S.qr, ACT(0));
    if constexpr (F32) { if (NT > 1) { VMW(); SWRITE_KF(1); SBAR(); SLOAD_F((const float*)Vh, KBASE(1)); } }
    MASKT(pA0, pA1, 0); partialSM(pA0, pA1, m_reg, mnA, alA);
    if (NT > 1) { VMW(); if constexpr (F32) { SWRITE_VF(1); SBAR(); if (NT > 2) SLOAD_F((const float*)Kh, KBASE(2)); } else SWRITE_H(1); }
    __syncthreads();
#define HALF_STEP(PX0, PX1, mnX, alX, PY0, PY1, alY, t, KB, VB, SB) do {                                                      \
        SBAR(); qkt<KB, SK>(PX0, PX1, K_lds, r32, hi, S.qr, ACT(t));                                             \
        finishSM(PY0, PY1, alY, l_reg, pa0, pa1, pa2, pa3); SBAR();                                                           \
        if ((t) + 1 < NT) { if constexpr (F32) { VMW(); SWRITE_KF(SB); SBAR(); SLOAD_F((const float*)Vh, KBASE((t) + 1)); }  \
                            else { SLOAD_H(Kh, Vh, KBASE((t) + 1)); } SBAR(); }                                               \
        pv_tile<VB, SK>(o, vb0, pa0, pa1, pa2, pa3, ACT((t) - 1)); MASKT(PX0, PX1, (t)); partialSM(PX0, PX1, m_reg, mnX, alX);                                        \
        __syncthreads();                                                                                                      \
        if ((t) + 1 < NT) { VMW(); if constexpr (F32) { SWRITE_VF(SB); SBAR(); if ((t) + 2 < NT) SLOAD_F((const float*)Kh, KBASE((t) + 2)); } \
                            else { SWRITE_H(SB); } }                                                                          \
        RESC(alX); __syncthreads(); } while (0)
    for (int t = 1; t + 1 < NT; t += 2) {
        HALF_STEP(pB0, pB1, mnB, alB, pA0, pA1, alA, t, 1, 0, 0);
        HALF_STEP(pA0, pA1, mnA, alA, pB0, pB1, alB, t + 1, 0, 1, 1);
    }
    const bool even = (NT & 1) == 0;
    if (even) { SBAR(); qkt<1, SK>(pB0, pB1, K_lds, r32, hi, S.qr, ACT(NT - 1)); SBAR(); }
#define QROW(e) (nxt.Q + (size_t)(wid * QBLK + r32) * (size_t)nxt.pitch + ((e) >> 1) * 16 + hi * 8 + ((e) & 1) * 4)
    if constexpr (F32) { SLOAD_F((const float*)nxt.K, kbn); SBAR();
#pragma unroll
        for (int e = 0; e < 8; ++e) S.tq[e] = *(const f32x4*)QROW(e); }
    else { SLOAD_HP(nxt.K, nxt.V, kbn, nxt.pitch); SBAR();
#pragma unroll
        for (int d0 = 0; d0 < 8; ++d0) S.qr[d0] = load8<TIn>(nxt.Q + (size_t)(wid * QBLK + r32) * (size_t)nxt.pitch + d0 * 16 + hi * 8); }
    SBAR();
    finishSM(pA0, pA1, alA, l_reg, pa0, pa1, pa2, pa3); SBAR();
    if constexpr (F32) {
#pragma unroll
        for (int e = 8; e < 16; ++e) S.tq[e] = *(const f32x4*)QROW(e); SBAR(); }
#undef QROW
    pv_tile<0, SK>(o, vb0, pa0, pa1, pa2, pa3, ACT(even ? NT - 2 : NT - 1));
    if (even) { MASKT(pB0, pB1, NT - 1); partialSM(pB0, pB1, m_reg, mnB, alB); __syncthreads(); RESC(alB);
        finishSM(pB0, pB1, alB, l_reg, pa0, pa1, pa2, pa3); SBAR(); pv_tile<1, SK>(o, vb0, pa0, pa1, pa2, pa3, ACT(NT - 1)); }
    SBAR(); SEAM_K0();
    if (hi == 0) { li_l[r32] = l_reg; cur.L[(size_t)(wid * QBLK + r32) * (size_t)cur.lpitch] = m_reg * SCALE + __builtin_amdgcn_logf(l_reg) * 0.6931471805599453f; }
    asm volatile("s_waitcnt lgkmcnt(0)" ::: "memory");
    float rli[16];
#pragma unroll
    for (int r = 0; r < 16; ++r) rli[r] = __builtin_amdgcn_rcpf(li_l[crow(r, hi)]);
    TOut* Ow = cur.O + (size_t)(wid * QBLK) * (size_t)cur.pitch;
#pragma unroll
    for (int r = 0; r < 16; ++r) { const int orow = crow(r, hi);
#pragma unroll
        for (int d0 = 0; d0 < 4; ++d0) { const float v = o[d0][r] * rli[r];
            if constexpr (same_t<TOut, float>::v) { Ow[(size_t)orow * (size_t)cur.pitch + d0 * 32 + r32] = v; }
            else { const float vn = __shfl_xor(v, 1);
                   if ((r32 & 1) == 0) *(unsigned*)(Ow + (size_t)orow * (size_t)cur.pitch + d0 * 32 + r32) = cvtpk(v, vn); } } }
    if constexpr (F32) {
#pragma unroll
        for (int d0 = 0; d0 < 8; ++d0) S.qr[d0] = pack8(S.tq[2 * d0], S.tq[2 * d0 + 1]); }
    __syncthreads();
#undef RESC
#undef KBASE
#undef ACT
#undef MASKT
#undef SEAM_K0
#undef HALF_STEP
}
#undef ROW
#undef ROWP
#undef SLOAD_HP
#undef VMW
#undef VMWN
#undef SLOAD_H
#undef SWRITE_HK
#undef SWRITE_HV
#undef SWRITE_H
#undef SLOAD_F
#undef SWRITE_KF
#undef SWRITE_VF
}
#ifndef ONE_LAUNCH
#define ONE_LAUNCH 1
#endif
#ifndef PROBE_SKIP
#define PROBE_SKIP 0
#endif
#ifndef NPASS
#define NPASS 1
#endif
#ifndef PROBE_DUP_PROLOGUE
#define PROBE_DUP_PROLOGUE 0
#endif
constexpr int NBATCH = 4, SEQ = 4096, DM = 2048, M = NBATCH * SEQ, INW = 7168, DFF = 5632, DEPTH = 2;
constexpr int C_Q = 2048, C_K = 5120, C_V = 6144;
constexpr float EPS = 1e-6f;
constexpr int NWAVES = 8;
constexpr size_t MiB = 1u << 20;
constexpr size_t WS_CTL = 0, CTL_ZERO_BYTES = 32 * 1024;
constexpr int CW_BAR = 4096;
constexpr size_t WS_RSQ = 5 * MiB;
constexpr int RT_OFF = 131072 + 1024 + 8192;
constexpr int XL_OFF = 131072 + 1024;
constexpr int MISC_OFF = 131072 + 320;
constexpr size_t WS_ROPE = 1 * MiB;
constexpr size_t WS_LSE = 3 * MiB;
constexpr size_t WS_W = 8 * MiB;
constexpr size_t W_IN_OFF = 0, W_OUT_OFF = 28 * MiB, W_GU_OFF = 36 * MiB, W_DN_OFF = 80 * MiB, W_LAYER = 102 * MiB;
constexpr size_t WS_XN = WS_W + DEPTH * W_LAYER;
constexpr size_t WS_Z = WS_XN + 64 * MiB;
constexpr size_t WS_END = WS_Z + 224 * MiB;
static_assert((size_t)INW * DM * 2 == 28 * MiB && (size_t)DM * DM * 2 == 8 * MiB && (size_t)2 * DFF * DM * 2 == 44 * MiB && (size_t)DM * DFF * 2 == 22 * MiB, "weight map");
static_assert((size_t)M * DM * 2 == 64 * MiB && (size_t)M * INW * 2 == 224 * MiB && (size_t)M * DFF * 2 <= 224 * MiB, "activation map");
constexpr int LDS_BYTES = 147456;

#define LAS __attribute__((address_space(3)))
typedef unsigned short bf16_t;
typedef unsigned u32x4 __attribute__((ext_vector_type(4)));
typedef unsigned u32x2 __attribute__((ext_vector_type(2)));
typedef float f32x4 __attribute__((ext_vector_type(4)));
typedef short bf16x8 __attribute__((ext_vector_type(8)));
#define LDS_WAIT() asm volatile("s_waitcnt lgkmcnt(0)" ::: "memory")

__device__ __forceinline__ unsigned f2bf(float f) { unsigned u = __builtin_bit_cast(unsigned, f); return (u + 0x7fffu + ((u >> 16) & 1u)) >> 16; }
__device__ __forceinline__ unsigned pk2(float lo, float hi) { return pg8::cvt_pk_bf16(lo, hi); }
__device__ __forceinline__ float bf_lo(unsigned w) { return __builtin_bit_cast(float, w << 16); }
__device__ __forceinline__ float bf_hi(unsigned w) { return __builtin_bit_cast(float, w & 0xffff0000u); }
__device__ __forceinline__ float wave_sum(float v) {
#pragma unroll
    for (int o = 1; o < 64; o <<= 1) v += __shfl_xor(v, o);
    return v;
}

struct Args { const float* in[16]; float* out; unsigned char* ws; int ph_lo, ph_hi; };

__device__ __forceinline__ void transpose_item(const float* W, int K, int N, bf16_t* WT, int mode, const float* kscale, LAS float* scr, int item, int lane) {
    const int nblk = N / 32, kb = item / nblk, nb = item % nblk, k0 = 64 * kb, n0 = 32 * nb;
    const int drow = (mode == 0 || mode == 3) ? n0 : ((n0 >> 7) * 256 + (n0 & 127) + (mode == 2 ? 128 : 0));
    f32x4 t[8];
#pragma unroll
    for (int i = 0; i < 8; ++i) t[i] = *(const f32x4*)(W + (size_t)(k0 + 8 * i + (lane >> 3)) * N + n0 + 4 * (lane & 7));
#pragma unroll
    for (int i = 0; i < 8; ++i) { const int kk = 8 * i + (lane >> 3); const float sc = kscale ? kscale[k0 + kk] : 1.f; LAS float* d = scr + kk * 33 + 4 * (lane & 7);
        d[0] = t[i][0] * sc; d[1] = t[i][1] * sc; d[2] = t[i][2] * sc; d[3] = t[i][3] * sc; }
    LDS_WAIT(); asm volatile("" ::: "memory");
    const int c = lane & 7;
#pragma unroll
    for (int j = 0; j < 4; ++j) { const int n = (lane >> 3) + 8 * j; const LAS float* s = scr + (8 * c) * 33 + n;
        int dn = n;
        if (mode == 3 && n0 >= 2048 && n0 < 6144) { const int d = (n0 & 127) + n; dn = ((d >> 4) & 3) * 32 + ((d >> 2) & 3) * 8 + (d >> 6) * 4 + (d & 3) - (n0 & 127); }
        u32x4 o; o.x = pk2(s[0 * 33], s[1 * 33]); o.y = pk2(s[2 * 33], s[3 * 33]); o.z = pk2(s[4 * 33], s[5 * 33]); o.w = pk2(s[6 * 33], s[7 * 33]);
        *(u32x4*)(WT + (size_t)(drow + dn) * K + k0 + 8 * c) = o; }
    LDS_WAIT(); asm volatile("" ::: "memory");
}
__device__ __forceinline__ void convert_rows(const float* X, bf16_t* out, float* rsq, int gw, int ngw, int lane) {
    for (int m = gw; m < M; m += ngw) {
        const f32x4* xr = (const f32x4*)(X + (size_t)m * DM) + lane;
        f32x4 v[8]; float s = 0.f;
#pragma unroll
        for (int j = 0; j < 8; ++j) { v[j] = xr[64 * j]; s += (v[j].x * v[j].x + v[j].y * v[j].y) + (v[j].z * v[j].z + v[j].w * v[j].w); }
        s = wave_sum(s); if (lane == 0) rsq[m] = s;
        u32x2* o8 = (u32x2*)(out + (size_t)m * DM) + lane;
#pragma unroll
        for (int j = 0; j < 8; ++j) { u32x2 w; w.x = pk2(v[j].x, v[j].y); w.y = pk2(v[j].z, v[j].w); o8[64 * j] = w; }
    }
}
__device__ __forceinline__ void qk_prep(bf16_t* Z, const float* qn, const float* kn, const float* rope, int gw, int ngw, int lane) {
    const int i4 = 4 * (lane & 15);
    const f32x4 gq1 = *(const f32x4*)(qn + i4), gq2 = *(const f32x4*)(qn + 64 + i4), gk1 = *(const f32x4*)(kn + i4), gk2 = *(const f32x4*)(kn + 64 + i4);
    for (int it = gw; it < M * 8; it += 4 * ngw) {
        bf16_t* p[4]; u32x2 a[4], b[4]; f32x4 cs[4], sn[4]; bool ok[4], isq[4];
#pragma unroll
        for (int j = 0; j < 4; ++j) { const int itj = it + j * ngw; ok[j] = itj < M * 8; const int row = ok[j] ? itj >> 3 : 0, head = (itj & 7) * 4 + (lane >> 4); isq[j] = head < 24;
            p[j] = Z + (size_t)row * INW + C_Q + head * 128 + i4; const int pos = row & (SEQ - 1);
            a[j] = *(const u32x2*)p[j]; b[j] = *(const u32x2*)(p[j] + 64);
            cs[j] = *(const f32x4*)(rope + (size_t)pos * 64 + i4); sn[j] = *(const f32x4*)(rope + (size_t)SEQ * 64 + (size_t)pos * 64 + i4); }
#pragma unroll
        for (int j = 0; j < 4; ++j) {
            const float x1[4] = {bf_lo(a[j].x), bf_hi(a[j].x), bf_lo(a[j].y), bf_hi(a[j].y)}, x2[4] = {bf_lo(b[j].x), bf_hi(b[j].x), bf_lo(b[j].y), bf_hi(b[j].y)};
            float ss = (x1[0] * x1[0] + x1[1] * x1[1]) + (x1[2] * x1[2] + x1[3] * x1[3]) + (x2[0] * x2[0] + x2[1] * x2[1]) + (x2[2] * x2[2] + x2[3] * x2[3]);
            ss += __shfl_xor(ss, 1); ss += __shfl_xor(ss, 2); ss += __shfl_xor(ss, 4); ss += __shfl_xor(ss, 8);
            const float rstd = __builtin_amdgcn_rsqf(ss * (1.f / 128.f) + EPS);
            const f32x4 g1 = isq[j] ? gq1 : gk1, g2 = isq[j] ? gq2 : gk2;
            float o1[4], o2[4];
#pragma unroll
            for (int e = 0; e < 4; ++e) { const float y1 = x1[e] * rstd * g1[e], y2 = x2[e] * rstd * g2[e]; o1[e] = y1 * cs[j][e] - y2 * sn[j][e]; o2[e] = y2 * cs[j][e] + y1 * sn[j][e]; }
            u32x2 wa, wb; wa.x = pk2(o1[0], o1[1]); wa.y = pk2(o1[2], o1[3]); wb.x = pk2(o2[0], o2[1]); wb.y = pk2(o2[2], o2[3]);
            if (ok[j]) { *(u32x2*)p[j] = wa; *(u32x2*)(p[j] + 64) = wb; }
        }
    }
}
#define GMLP_DECL(P) u32x2 P##uu[8]; f32x4 P##w[8]; u32x4 P##raw[4]; float P##bs
#define GMLP_LOAD(P, Zp, wsp_, bsp_, cidx_, g_) do { const int row0_ = (cidx_) * 128; P##bs = (bsp_)[(g_) * 128 + (tid >> 6) * 16 + (tid & 15)]; \
    { const int wv_ = tid >> 6, ln_ = tid & 63; const bf16_t* up_ = (Zp) + (size_t)(row0_ + wv_ * 16 + (ln_ & 15)) * INW + (g_) * 128 + 4 * (ln_ >> 4); \
      _Pragma("unroll") for (int ct = 0; ct < 8; ++ct) P##uu[ct] = *(const u32x2*)(up_ + 16 * ct); } \
    { const float* wp_ = (wsp_) + ((size_t)(g_) * 128 + (tid >> 2)) * 128 + (tid & 3) * 32; \
      _Pragma("unroll") for (int q = 0; q < 8; ++q) P##w[q] = *(const f32x4*)(wp_ + 4 * q); } \
    { const bf16_t* vp_ = (Zp) + (size_t)(row0_ + (tid >> 2)) * INW + 1024 + (g_) * 128 + (tid & 3) * 32; \
      _Pragma("unroll") for (int q = 0; q < 4; ++q) P##raw[q] = *(const u32x4*)(vp_ + 8 * q); } \
    asm volatile("" ::: "memory"); } while (0)
__device__ __forceinline__ void gmlp_unit(LAS unsigned char* lds, bf16_t* Z, const float* ln_g, const float* ln_b, const float bs, const u32x2 (&uu)[8], const f32x4 (&wreg)[8], const u32x4 (&raw)[4], int cidx, int g, int tid) {
    constexpr int LSTR = 272;
    LAS unsigned char* VT = lds; LAS unsigned char* WS = lds + 128 * LSTR;
    const int row0 = cidx * 128;
    {
        const int j = tid >> 2, cq = (tid & 3) * 32;
        float x[32];
#pragma unroll
        for (int q = 0; q < 4; ++q)
#pragma unroll
            for (int e = 0; e < 4; ++e) { x[8 * q + 2 * e] = bf_lo(raw[q][e]); x[8 * q + 2 * e + 1] = bf_hi(raw[q][e]); }
        float s = 0.f;
#pragma unroll
        for (int c = 0; c < 32; ++c) s += x[c];
        s += __shfl_xor(s, 1); s += __shfl_xor(s, 2);
        const float mean = s * (1.f / 128.f); float q2 = 0.f;
#pragma unroll
        for (int c = 0; c < 32; ++c) { x[c] -= mean; q2 += x[c] * x[c]; }
        q2 += __shfl_xor(q2, 1); q2 += __shfl_xor(q2, 2);
        const float rstd = __builtin_amdgcn_rsqf(q2 * (1.f / 128.f) + EPS);
        const float* gp = ln_g + g * 128 + cq; const float* bp = ln_b + g * 128 + cq;
#pragma unroll
        for (int c4 = 0; c4 < 8; ++c4) { const f32x4 gg = *(const f32x4*)(gp + 4 * c4), bb = *(const f32x4*)(bp + 4 * c4);
#pragma unroll
            for (int e = 0; e < 4; ++e) { const int c = 4 * c4 + e; const float y = x[c] * rstd * gg[e] + bb[e];
                *(LAS unsigned short*)(VT + (cq + c) * LSTR + j * 2) = (unsigned short)f2bf(y); } }
    }
    {
        const int i = tid >> 2, jq = (tid & 3) * 32;
#pragma unroll
        for (int q = 0; q < 4; ++q) { f32x4 a = wreg[2 * q], b = wreg[2 * q + 1];
            const int j0 = jq + 8 * q;
#pragma unroll
            for (int e = 0; e < 4; ++e) { if (j0 + e > i) a[e] = 0.f; if (j0 + 4 + e > i) b[e] = 0.f; }
            u32x4 w; w.x = pk2(a[0], a[1]); w.y = pk2(a[2], a[3]); w.z = pk2(b[0], b[1]); w.w = pk2(b[2], b[3]);
            *(LAS u32x4*)(WS + i * LSTR + j0 * 2) = w; }
    }
    __syncthreads();
    const int wv = tid >> 6, lane = tid & 63, fr = lane & 15, fq = lane >> 4;
    f32x4 acc[8];
#pragma unroll
    for (int ct = 0; ct < 8; ++ct) acc[ct] = (f32x4){0.f, 0.f, 0.f, 0.f};
#pragma unroll
    for (int ks = 0; ks < 4; ++ks) {
        const bf16x8 bw = *(const LAS bf16x8*)(WS + (wv * 16 + fr) * LSTR + (ks * 32 + fq * 8) * 2);
#pragma unroll
        for (int ct = 0; ct < 8; ++ct) { const bf16x8 av = *(const LAS bf16x8*)(VT + (ct * 16 + fr) * LSTR + (ks * 32 + fq * 8) * 2);
            acc[ct] = __builtin_amdgcn_mfma_f32_16x16x32_bf16(av, bw, acc[ct], 0, 0, 0); }
    }
    {
        const int i = wv * 16 + fr;
        bf16_t* up = Z + (size_t)(row0 + i) * INW + g * 128 + 4 * fq;
#pragma unroll
        for (int ct = 0; ct < 8; ++ct) {
            u32x2 w; w.x = pk2(bf_lo(uu[ct].x) * (acc[ct][0] + bs), bf_hi(uu[ct].x) * (acc[ct][1] + bs)); w.y = pk2(bf_lo(uu[ct].y) * (acc[ct][2] + bs), bf_hi(uu[ct].y) * (acc[ct][3] + bs));
            *(u32x2*)(up + 16 * ct) = w; }
    }
    __syncthreads();
}
__device__ __forceinline__ void merge_rows(bf16_t* Z, const float* LSE, const float* ga, const float* gb, int gw, int ngw, int lane) {
    const int ch0 = lane * 16, head = lane >> 3;
    f32x4 gav[2][2], gbv[2][2];
#pragma unroll
    for (int h2 = 0; h2 < 2; ++h2) { gav[h2][0] = *(const f32x4*)(ga + ch0 + 8 * h2); gav[h2][1] = *(const f32x4*)(ga + ch0 + 8 * h2 + 4); gbv[h2][0] = *(const f32x4*)(gb + ch0 + 8 * h2); gbv[h2][1] = *(const f32x4*)(gb + ch0 + 8 * h2 + 4); }
    for (int m0 = gw; m0 < M; m0 += 2 * ngw) {
        u32x4 q0[2][2], q1[2][2], q2[2][2], aa[2][2]; float l0[2], l1[2], l2[2]; bool ok[2];
#pragma unroll
        for (int r = 0; r < 2; ++r) { const int m = m0 + r * ngw; ok[r] = m < M; const int mm = ok[r] ? m : m0; const bf16_t* zr = Z + (size_t)mm * INW;
            l0[r] = LSE[((size_t)0 * M + mm) * 8 + head]; l1[r] = LSE[((size_t)1 * M + mm) * 8 + head]; l2[r] = LSE[((size_t)2 * M + mm) * 8 + head];
#pragma unroll
            for (int h2 = 0; h2 < 2; ++h2) { q0[r][h2] = *(const u32x4*)(zr + C_Q + ch0 + 8 * h2); q1[r][h2] = *(const u32x4*)(zr + C_Q + 1024 + ch0 + 8 * h2); q2[r][h2] = *(const u32x4*)(zr + C_Q + 2048 + ch0 + 8 * h2); aa[r][h2] = *(const u32x4*)(zr + ch0 + 8 * h2); } }
#pragma unroll
        for (int r = 0; r < 2; ++r) {
            const float mx = fmaxf(l0[r], fmaxf(l1[r], l2[r]));
            float e0 = __builtin_amdgcn_exp2f((l0[r] - mx) * 1.4426950408889634f), e1 = __builtin_amdgcn_exp2f((l1[r] - mx) * 1.4426950408889634f), e2 = __builtin_amdgcn_exp2f((l2[r] - mx) * 1.4426950408889634f);
            const float inv = __builtin_amdgcn_rcpf(e0 + e1 + e2); e0 *= inv; e1 *= inv; e2 *= inv;
            float ob[16], oa[16];
#pragma unroll
            for (int h2 = 0; h2 < 2; ++h2)
#pragma unroll
                for (int e = 0; e < 4; ++e) {
                    ob[8 * h2 + 2 * e] = e0 * bf_lo(q0[r][h2][e]) + e1 * bf_lo(q1[r][h2][e]) + e2 * bf_lo(q2[r][h2][e]); ob[8 * h2 + 2 * e + 1] = e0 * bf_hi(q0[r][h2][e]) + e1 * bf_hi(q1[r][h2][e]) + e2 * bf_hi(q2[r][h2][e]);
                    oa[8 * h2 + 2 * e] = bf_lo(aa[r][h2][e]); oa[8 * h2 + 2 * e + 1] = bf_hi(aa[r][h2][e]); }
            float sb = 0.f, sa = 0.f;
#pragma unroll
            for (int c = 0; c < 16; ++c) { sb += ob[c] * ob[c]; sa += oa[c] * oa[c]; }
            sb = wave_sum(sb); sa = wave_sum(sa);
            const float rb = __builtin_amdgcn_rsqf(sb * (1.f / 1024.f) + EPS), ra = __builtin_amdgcn_rsqf(sa * (1.f / 1024.f) + EPS);
            bf16_t* mr = Z + (size_t)(m0 + r * ngw) * INW;
            if (ok[r]) {
#pragma unroll
                for (int h2 = 0; h2 < 2; ++h2) {
                    const f32x4 ga0 = gav[h2][0], ga1 = gav[h2][1], gb0 = gbv[h2][0], gb1 = gbv[h2][1];
                    u32x4 wa, wb; const float* A = oa + 8 * h2; const float* B = ob + 8 * h2;
                    wa.x = pk2(A[0] * ra * ga0[0], A[1] * ra * ga0[1]); wa.y = pk2(A[2] * ra * ga0[2], A[3] * ra * ga0[3]); wa.z = pk2(A[4] * ra * ga1[0], A[5] * ra * ga1[1]); wa.w = pk2(A[6] * ra * ga1[2], A[7] * ra * ga1[3]);
                    wb.x = pk2(B[0] * rb * gb0[0], B[1] * rb * gb0[1]); wb.y = pk2(B[2] * rb * gb0[2], B[3] * rb * gb0[3]); wb.z = pk2(B[4] * rb * gb1[0], B[5] * rb * gb1[1]); wb.w = pk2(B[6] * rb * gb1[2], B[7] * rb * gb1[3]);
                    *(u32x4*)(mr + ch0 + 8 * h2) = wa; *(u32x4*)(mr + 1024 + ch0 + 8 * h2) = wb;
                }
            }
        }
    }
}
typedef swa::BlockRef<__hip_bfloat16, __hip_bfloat16> ABlock;
__device__ __forceinline__ ABlock attn_ref(int id, bf16_t* Zb, float* LSE) {
    __hip_bfloat16* Z = (__hip_bfloat16*)Zb;
    const int bh = id / 48, w48 = id - bh * 48, g = w48 >> 4, w16 = w48 & 15, b = bh >> 3, h = bh & 7;
    const int r = 1 << (2 * g), nqb = 16 >> (2 * g), rho = w16 / nqb, qb = w16 - rho * nqb;
    const size_t tok0 = (size_t)b * SEQ + rho, tokq = tok0 + (size_t)r * 256 * qb;
    ABlock R;
    R.K = Z + tok0 * INW + C_K + h * 128; R.V = Z + tok0 * INW + C_V + h * 128;
    R.Q = Z + tokq * INW + C_Q + g * 1024 + h * 128; R.O = Z + tokq * INW + C_Q + g * 1024 + h * 128;
    R.L = LSE + ((size_t)g * M + tokq) * 8 + h; R.P0 = 256 * qb; R.pitch = r * INW; R.lpitch = r * 8;
    return R;
}

#define RLX_AGENT __ATOMIC_RELAXED, __HIP_MEMORY_SCOPE_AGENT
#define XB_TMO      128
#define XB_XCNT(j)  (256  + 64 * (j))
#define XB_XSUB(j)  (1280 + 64 * (j))
#define XB_XGEN(j)  (2304 + 64 * (j))
#define XB_TOP      3328
#define XB_TOPGEN   3392
#define XCD_BAR_WORDS 3456
#define XB_SPIN_CAP (1u << 18)

__device__ __forceinline__ unsigned xb_ld(unsigned* p)              { return __hip_atomic_load(p, __ATOMIC_RELAXED, __HIP_MEMORY_SCOPE_AGENT); }
__device__ __forceinline__ unsigned xb_add(unsigned* p, unsigned v) { return __hip_atomic_fetch_add(p, v, __ATOMIC_RELAXED, __HIP_MEMORY_SCOPE_AGENT); }
__device__ __forceinline__ unsigned xb_xcc_id() { return (unsigned)__builtin_amdgcn_s_getreg((3 << 11) | 20) & 0xFu; }
#define XB_SPIN(cond, bar) do { unsigned _sp = 0; while (cond) { __builtin_amdgcn_s_sleep(1); \
    if ((++_sp & 255u) == 0u) { if (xb_ld(&(bar)[XB_TMO])) break; if (_sp > XB_SPIN_CAP) { atomicAdd(&(bar)[XB_TMO], 1u); break; } } } } while (0)

struct XcdBarrier {
    unsigned* bar; unsigned x;
    volatile LAS unsigned* st;
};

__device__ __forceinline__ XcdBarrier xcd_barrier_post(unsigned* bar, volatile LAS unsigned* st) {
    XcdBarrier b; b.bar = bar; b.x = xb_xcc_id(); b.st = st;
    if (threadIdx.x == 0) (void)xb_add(&bar[XB_XCNT(b.x)], 1u);
    return b;
}
__device__ __forceinline__ void xcd_barrier_complete(unsigned* bar, unsigned x, unsigned& nloc, unsigned& nx) {
    const unsigned G = gridDim.x * gridDim.y * gridDim.z;
    unsigned sum, cnt, mine, sp = 0u;
    for (;;) {
        sum = 0u; cnt = 0u; mine = 0u;
#pragma unroll
        for (unsigned j = 0; j < 16; ++j) { const unsigned c = xb_ld(&bar[XB_XCNT(j)]); sum += c; cnt += (c > 0u) ? 1u : 0u; mine = (j == x) ? c : mine; }
        if (sum == G) break;
        __builtin_amdgcn_s_sleep(1);
        if ((++sp & 255u) == 0u) { if (xb_ld(&bar[XB_TMO])) break; if (sp > XB_SPIN_CAP) { atomicAdd(&bar[XB_TMO], 1u); break; } }
    }
    nloc = mine > 0u ? mine : 1u; nx = cnt > 0u ? cnt : 1u;
}

__device__ __forceinline__ void xcd_barrier(const XcdBarrier& b) {
    asm volatile("s_waitcnt vmcnt(0)" ::: "memory");
    __syncthreads();
    if (threadIdx.x == 0) {
        unsigned* bar = b.bar;
        __builtin_amdgcn_s_waitcnt(0);
        unsigned nloc = b.st[0], nx = b.st[1];
        if (nloc == 0u) { xcd_barrier_complete(bar, b.x, nloc, nx); b.st[0] = nloc; b.st[1] = nx; }
        const unsigned old = xb_add(&bar[XB_XSUB(b.x)], 1u);
        const unsigned gen = old / nloc;
        if (old + 1u == (gen + 1u) * nloc) {
            __builtin_amdgcn_fence(__ATOMIC_RELEASE, "agent");
            asm volatile("s_waitcnt vmcnt(0)" ::: "memory");
            const unsigned og = xb_add(&bar[XB_TOP], 1u);
            const unsigned tg = og / nx;
            if (og + 1u == (tg + 1u) * nx) xb_add(&bar[XB_TOPGEN], 1u);
            else XB_SPIN(xb_ld(&bar[XB_TOPGEN]) == tg, bar);
            __builtin_amdgcn_fence(__ATOMIC_ACQUIRE, "agent");
            xb_add(&bar[XB_XGEN(b.x)], 1u);
            asm volatile("s_waitcnt vmcnt(0)" ::: "memory");
        } else {
            XB_SPIN(xb_ld(&bar[XB_XGEN(b.x)]) == gen, bar);
            __builtin_amdgcn_fence(__ATOMIC_ACQUIRE, "agent");
            asm volatile("s_waitcnt vmcnt(0)" ::: "memory");
        }
    }
    __syncthreads();
}

constexpr int PH_PER_LAYER = 7, N_PHASES = 1 + DEPTH * PH_PER_LAYER;
typedef const __attribute__((address_space(4))) Args* KArgs;
#define KARGS(A) KArgs A = (KArgs)__builtin_amdgcn_kernarg_segment_ptr(); asm volatile("" : "+s"(A))
#define PH_COMMON() KARGS(A); const int tid = ltid(), lane = tid & 63, wave = __builtin_amdgcn_readfirstlane(tid >> 6); const int G = gridDim.x, gw = blockIdx.x * NWAVES + wave, ngw = G * NWAVES; \
    unsigned char* ws = A->ws; (void)lane; (void)gw; (void)ngw; (void)ws
__global__ void __launch_bounds__(NWAVES * 64, 2) fwd_kernel(Args args_) {
    extern __shared__ __attribute__((aligned(16))) unsigned char lds[];
    int ph, ph_hi; { KARGS(A0); ph = A0->ph_lo; ph_hi = A0->ph_hi; }
#if ONE_LAUNCH
    { LAS unsigned* misc = (LAS unsigned*)((LAS unsigned char*)lds + MISC_OFF); if (threadIdx.x < 32) misc[threadIdx.x] = 0u; __syncthreads();
      KARGS(A0); (void)xcd_barrier_post((unsigned*)(A0->ws + WS_CTL) + CW_BAR, (volatile LAS unsigned*)(misc + 8)); }
#endif
#pragma unroll 1
    for (; ph < ph_hi; ++ph) {
#if NPASS > 1
        const int pe = ph >= N_PHASES ? ph - N_PHASES : ph;
        if (ph == N_PHASES) { KARGS(Az); float* rz = (float*)(Az->ws + WS_RSQ) + M; for (int i = blockIdx.x * 512 + threadIdx.x; i < 3 * M; i += gridDim.x * 512) rz[i] = 0.f; }
#else
        const int pe = ph;
#endif
        const int l = pe == 0 ? 0 : (pe - 1) / PH_PER_LAYER, s = pe == 0 ? -1 : (pe - 1) % PH_PER_LAYER;
        switch ((NPASS > 1 && ph < N_PHASES && ((PROBE_SKIP >> (s + 1)) & 1)) ? 99 : s) {
        case -1: for (int rep_ = 0; rep_ <= PROBE_DUP_PROLOGUE; ++rep_) {
            PH_COMMON(); LAS unsigned char* lds3 = (LAS unsigned char*)lds;
            LAS float* scr = (LAS float*)(lds3 + wave * 16384);
            constexpr int I_IN = (DM / 64) * (INW / 32), I_OUT = (DM / 64) * (DM / 32), I_G = (DM / 64) * (DFF / 32), I_D = (DFF / 64) * (DM / 32), I_L = I_IN + I_OUT + 2 * I_G + I_D;
            for (int it = gw; it < DEPTH * I_L; it += ngw) {
                const int li = it / I_L; int r = it - li * I_L; unsigned char* wd = ws + WS_W + (size_t)li * W_LAYER;
                if (r < I_IN) { transpose_item(A->in[2] + (size_t)li * DM * INW, DM, INW, (bf16_t*)(wd + W_IN_OFF), 3, A->in[1] + (size_t)li * DM, scr, r, lane); continue; } r -= I_IN;
                if (r < I_OUT) { transpose_item(A->in[11] + (size_t)li * DM * DM, DM, DM, (bf16_t*)(wd + W_OUT_OFF), 0, nullptr, scr, r, lane); continue; } r -= I_OUT;
                if (r < I_G) { transpose_item(A->in[13] + (size_t)li * DM * DFF, DM, DFF, (bf16_t*)(wd + W_GU_OFF), 1, A->in[12] + (size_t)li * DM, scr, r, lane); continue; } r -= I_G;
                if (r < I_G) { transpose_item(A->in[14] + (size_t)li * DM * DFF, DM, DFF, (bf16_t*)(wd + W_GU_OFF), 2, A->in[12] + (size_t)li * DM, scr, r, lane); continue; } r -= I_G;
                transpose_item(A->in[15] + (size_t)li * DFF * DM, DFF, DM, (bf16_t*)(wd + W_DN_OFF), 0, nullptr, scr, r, lane);
            }
            float* rope = (float*)(ws + WS_ROPE);
            for (int e = blockIdx.x * (NWAVES * 64) + tid; e < SEQ * 64; e += G * NWAVES * 64) {
                const int pos = e >> 6, i = e & 63;
                const float inv_freq = __builtin_amdgcn_exp2f(-(float)(2 * i) * (1.0f / 128.0f) * 13.287712379549449f);
                const float ang = (float)pos * inv_freq;
                double rev = (double)ang * 0.15915494309189535; rev -= __builtin_rint(rev);
                ((unsigned*)rope)[e] = pk2(__builtin_amdgcn_cosf((float)rev), __builtin_amdgcn_sinf((float)rev));
            }
            convert_rows(A->in[0], (bf16_t*)(ws + WS_XN), (float*)(ws + WS_RSQ), gw, ngw, lane);
        } break;
#ifndef NO_G1
        case 0: {
            PH_COMMON();
            pg8::Gemm g{(const bf16_t*)(ws + WS_XN), (const bf16_t*)(ws + WS_W + (size_t)l * W_LAYER + W_IN_OFF), M, INW, DM, DM}; pg8::StaticOrder S; S.init(M, INW, G, (int)blockIdx.x);
            pg8::RowScale rsc{(const float*)(ws + WS_RSQ) + (size_t)(l == 0 ? 0 : 2) * 8 * M, l == 0 ? 1 : 8, M, (LAS float*)((LAS unsigned char*)lds + RT_OFF)};
            pg8::EpiZ E{(bf16_t*)(ws + WS_Z), INW, rsc, A->in[7] + (size_t)l * 128, A->in[8] + (size_t)l * 128, (const float*)(ws + WS_ROPE), (LAS float*)((LAS unsigned char*)lds + XL_OFF)};
            pg8::gemm_phase<pg8::EpiZ, pg8::StaticOrder, true, true>((LAS unsigned char*)lds, g, S, E);
        } break;
#endif
#ifndef NO_MIX
        case 1: {
            PH_COMMON(); bf16_t* Z = (bf16_t*)(ws + WS_Z);
            const float* lng = A->in[3] + (size_t)l * 1024; const float* lnb = A->in[4] + (size_t)l * 1024;
            const float* wsp = A->in[5] + (size_t)l * 8 * 128 * 128; const float* bsp = A->in[6] + (size_t)l * 1024;
            {
                const int u0 = blockIdx.x, u1 = u0 + 256, u2 = u0 + 512, u3 = u0 + 768; GMLP_DECL(a_); GMLP_DECL(b_);
                GMLP_LOAD(a_, Z, wsp, bsp, u0 >> 3, u0 & 7); GMLP_LOAD(b_, Z, wsp, bsp, u1 >> 3, u1 & 7);
                gmlp_unit((LAS unsigned char*)lds, Z, lng, lnb, a_bs, a_uu, a_w, a_raw, u0 >> 3, u0 & 7, tid);
                GMLP_LOAD(a_, Z, wsp, bsp, u2 >> 3, u2 & 7);
                gmlp_unit((LAS unsigned char*)lds, Z, lng, lnb, b_bs, b_uu, b_w, b_raw, u1 >> 3, u1 & 7, tid);
                GMLP_LOAD(b_, Z, wsp, bsp, u3 >> 3, u3 & 7);
                gmlp_unit((LAS unsigned char*)lds, Z, lng, lnb, a_bs, a_uu, a_w, a_raw, u2 >> 3, u2 & 7, tid);
                gmlp_unit((LAS unsigned char*)lds, Z, lng, lnb, b_bs, b_uu, b_w, b_raw, u3 >> 3, u3 & 7, tid);
            }
        } break;
#endif
#ifndef NO_ATTN
        case 2: {
            KARGS(A); bf16_t* Z = (bf16_t*)(A->ws + WS_Z); float* LSE = (float*)(A->ws + WS_LSE); const int G = gridDim.x;
            constexpr int TOTAL = NBATCH * 8 * 48;
            const bool xl8 = (G == 256); const int vcu = (blockIdx.x & 7) * 32 + (blockIdx.x >> 3);
#define ATT_ID(i) (xl8 ? ((vcu >> 3) * 48 + ((i) >> 1) * 16 + 2 * (vcu & 7) + ((i) & 1)) : ((int)blockIdx.x + (i) * G))
#define ATT_MORE(i) (xl8 ? (i) < 6 : ((int)blockIdx.x + (i) * G) < TOTAL)
            int i = 0;
            if (ATT_MORE(0)) {
                ABlock cur = attn_ref(ATT_ID(0), Z, LSE);
                swa::Seam<__hip_bfloat16> S;
                swa::causal_swa_prime<__hip_bfloat16, __hip_bfloat16>(cur, 129, (char*)lds, S);
                for (;;) {
                    const bool last = !ATT_MORE(i + 1);
                    const ABlock nxt = last ? cur : attn_ref(ATT_ID(i + 1), Z, LSE);
                    swa::causal_swa_block<__hip_bfloat16, __hip_bfloat16>(cur, nxt, SEQ, 129, (char*)lds, S);
                    if (last) break;
                    cur = nxt; ++i;
                }
            }
#undef ATT_ID
#undef ATT_MORE
        } break;
#endif
#ifndef NO_MERGE
        case 3: { PH_COMMON(); merge_rows((bf16_t*)(ws + WS_Z), (const float*)(ws + WS_LSE), A->in[9] + (size_t)l * 1024, A->in[10] + (size_t)l * 1024, gw, ngw, lane); } break;
#endif
#ifndef NO_G5
        case 4: {
            PH_COMMON();
            pg8::Gemm g{(const bf16_t*)(ws + WS_Z), (const bf16_t*)(ws + WS_W + (size_t)l * W_LAYER + W_OUT_OFF), M, DM, DM, INW}; pg8::StaticOrder S; S.init(M, DM, G, (int)blockIdx.x);
            pg8::EpiRes E{(bf16_t*)(ws + WS_XN), nullptr, DM, (float*)(ws + WS_RSQ) + (size_t)(l == 0 ? 1 : 3) * 8 * M, M, (LAS float*)((LAS unsigned char*)lds + XL_OFF)};
            pg8::gemm_phase<pg8::EpiRes, pg8::StaticOrder, true, true>((LAS unsigned char*)lds, g, S, E);
        } break;
#endif
#ifndef NO_G7
        case 5: {
            PH_COMMON();
            pg8::Gemm g{(const bf16_t*)(ws + WS_XN), (const bf16_t*)(ws + WS_W + (size_t)l * W_LAYER + W_GU_OFF), M, 2 * DFF, DM, DM}; pg8::StaticOrder S; S.init(M, 2 * DFF, G, (int)blockIdx.x);
            pg8::RowScale rsc{(const float*)(ws + WS_RSQ) + (size_t)(l == 0 ? 1 : 3) * 8 * M, 8, M, (LAS float*)((LAS unsigned char*)lds + RT_OFF)};
            pg8::EpiSwiGLU E{(bf16_t*)(ws + WS_Z), DFF, rsc};
            pg8::gemm_phase<pg8::EpiSwiGLU, pg8::StaticOrder, true, true>((LAS unsigned char*)lds, g, S, E);
        } break;
#endif
#ifndef NO_G8
        case 6: {
            PH_COMMON();
            pg8::Gemm g{(const bf16_t*)(ws + WS_Z), (const bf16_t*)(ws + WS_W + (size_t)l * W_LAYER + W_DN_OFF), M, DM, DFF, DFF}; pg8::StaticOrder S; S.init(M, DM, G, (int)blockIdx.x);
            pg8::EpiRes E{(bf16_t*)(ws + WS_XN), l == 0 ? (float*)nullptr : A->out, DM, l == 0 ? (float*)(ws + WS_RSQ) + (size_t)2 * 8 * M : (float*)nullptr, M, (LAS float*)((LAS unsigned char*)lds + XL_OFF)};
            pg8::gemm_phase<pg8::EpiRes, pg8::StaticOrder, true, true>((LAS unsigned char*)lds, g, S, E);
        } break;
#endif
        default: break;
        }
#if ONE_LAUNCH
        if (ph + 1 < ph_hi && s != 1) {
            if (ph_hi < 0) cg::this_grid().sync();
            { KARGS(Ab); XcdBarrier b; b.bar = (unsigned*)(Ab->ws + WS_CTL) + CW_BAR; b.x = xb_xcc_id(); b.st = (volatile LAS unsigned*)((LAS unsigned char*)lds + MISC_OFF) + 8; xcd_barrier(b); }
        }
#endif
    }
}

extern "C" void kernel_launch(void* const* d_in, const int* in_sizes, int n_in, void* d_out, int out_size, void* d_ws, size_t ws_size, hipStream_t stream) {
    static int grid = 0;
    if (grid == 0) {
        if (n_in != 16 || out_size != M * DM || ws_size < WS_END) { fprintf(stderr, "kernel_launch: unexpected shapes (n_in %d out %d ws %zu)\n", n_in, out_size, ws_size); grid = -1; return; }
        int dev = 0, cus = 0, per_cu = 0;
        (void)hipGetDevice(&dev); (void)hipDeviceGetAttribute(&cus, hipDeviceAttributeMultiprocessorCount, dev);
        if (hipFuncSetAttribute((const void*)fwd_kernel, hipFuncAttributeMaxDynamicSharedMemorySize, LDS_BYTES) != hipSuccess) fprintf(stderr, "kernel_launch: hipFuncSetAttribute failed\n");
        if (hipOccupancyMaxActiveBlocksPerMultiprocessor(&per_cu, (const void*)fwd_kernel, NWAVES * 64, LDS_BYTES) != hipSuccess || per_cu < 1) per_cu = 1;
        (void)hipGetLastError();
        if (cus <= 0) cus = 256;
        if (cus * per_cu < 256) { fprintf(stderr, "kernel_launch: needs 256 co-resident workgroups (have %d x %d)\n", cus, per_cu); grid = -1; return; }
        grid = 256;
    }
    if (grid < 0) return;
    static_assert((CW_BAR + 3456) * 4 <= (int)CTL_ZERO_BYTES, "barrier words inside the zeroed region");
    (void)hipMemsetAsync((char*)d_ws + WS_CTL, 0, CTL_ZERO_BYTES, stream);
    Args a{};
    for (int i = 0; i < 16; ++i) a.in[i] = (const float*)d_in[i];
    a.out = (float*)d_out; a.ws = (unsigned char*)d_ws;
#if ONE_LAUNCH
    a.ph_lo = 0; a.ph_hi = NPASS * N_PHASES;
    void* kargs[] = {&a};
    hipError_t e = hipLaunchCooperativeKernel((const void*)fwd_kernel, dim3(grid), dim3(NWAVES * 64), kargs, LDS_BYTES, stream);
    if (e != hipSuccess) fprintf(stderr, "kernel_launch: cooperative launch failed: %s (grid %d)\n", hipGetErrorString(e), grid);
#else
    for (int ph = 0; ph < N_PHASES; ++ph) { a.ph_lo = ph; a.ph_hi = ph + 1; hipLaunchKernelGGL(fwd_kernel, dim3(grid), dim3(NWAVES * 64), LDS_BYTES, stream, a); }
#endif
}
```
